# Optimizing an MI355X kernel written in HIP

```python
import jax, jax.numpy as jnp
from jax import lax
import numpy as np

D_MODEL = 4096
BATCH = 4
SEQ = 2048
DEPTH = 2

CHUNK = 64
N_META = 16
N_MIXERS = 2
N_RWKV_LAYERS = (DEPTH + 1) // 2
N_SB_LAYERS = DEPTH // 2
RWKV_HEAD = 64
RWKV_HEADS = D_MODEL // RWKV_HEAD
N_MU = 6
D_DECAY_LORA = 128
D_AAA_LORA = 128
D_GATE_LORA = 480
SB_HEAD = 128
SB_HEADS = D_MODEL // SB_HEAD
Q_BLOCK = 128
D_FF = 4 * D_MODEL
LN_EPS = 1e-5
GN_EPS = 64e-5
L2_EPS = 1e-12
DEEPNORM_ALPHA = (2 * DEPTH) ** 0.25
DEEPNORM_BETA = (8 * DEPTH) ** -0.25

kernel_name = "hybrid_rwkv7_stickbreaking_deepnorm"


def layer_norm(x, g, b):
    xf = x.astype(jnp.float32)
    mu = jnp.mean(xf, axis=-1, keepdims=True)
    var = jnp.mean(jnp.square(xf - mu), axis=-1, keepdims=True)
    return ((xf - mu) * lax.rsqrt(var + LN_EPS)).astype(x.dtype) * g + b


def token_shift(x):
    return jnp.pad(x[:, :-1], ((0, 0), (1, 0), (0, 0)))


def rwkv7_time_mix(x, mu, w_rkv, w0, w1, w2, a0, a1, a2, g1, g2,
                   k_k, k_a, r_k, gn_g, gn_b, w_o):
    B, T, D = x.shape
    H, N = RWKV_HEADS, RWKV_HEAD
    f32 = jnp.float32
    xx = token_shift(x) - x
    mixed = x[None] + xx[None] * mu[:, None, None, :]
    rkv = jnp.einsum('nbtd,nde->nbte', mixed[:3], w_rkv)
    r, k, v = rkv[0], rkv[1], rkv[2]
    xw, xa, xg = mixed[3], mixed[4], mixed[5]

    w_log = -jax.nn.softplus(-(w0 + jnp.tanh(xw @ w1) @ w2)) - 0.5
    decay = jnp.exp(-jnp.exp(w_log.astype(f32)))
    a = jax.nn.sigmoid(a0 + (xa @ a1) @ a2)
    g = jax.nn.sigmoid(xg @ g1) @ g2

    def heads(z):
        return z.reshape(B, T, H, N).astype(f32)

    kk = heads(k * k_k)
    kk = kk / jnp.maximum(jnp.sqrt(jnp.sum(jnp.square(kk), axis=-1, keepdims=True)), L2_EPS)
    k = k * (1.0 + (a - 1.0) * k_a)
    r_h, k_h, v_h, a_h, w_h = heads(r), heads(k), heads(v), heads(a), decay.reshape(B, T, H, N)

    def step(S, inp):
        r_t, w_t, k_t, v_t, kk_t, a_t = inp
        s_kk = jnp.einsum('bhij,bhj->bhi', S, kk_t)
        S = (S * w_t[:, :, None, :]
             - jnp.einsum('bhi,bhj->bhij', s_kk, kk_t * a_t)
             + jnp.einsum('bhi,bhj->bhij', v_t, k_t))
        return S, jnp.einsum('bhij,bhj->bhi', S, r_t)

    xs = tuple(jnp.moveaxis(z, 1, 0) for z in (r_h, w_h, k_h, v_h, kk, a_h))
    S0 = jnp.zeros((B, H, N, N), f32)
    _, ys = lax.scan(step, S0, xs)
    y = jnp.moveaxis(ys, 0, 1)

    mu_y = jnp.mean(y, axis=-1, keepdims=True)
    var_y = jnp.mean(jnp.square(y - mu_y), axis=-1, keepdims=True)
    y_n = ((y - mu_y) * lax.rsqrt(var_y + GN_EPS)).reshape(B, T, D) * gn_g + gn_b
    bonus = (jnp.sum(r_h * k_h * r_k, axis=-1, keepdims=True) * v_h).reshape(B, T, D)
    return ((y_n + bonus).astype(x.dtype) * g) @ w_o


def stick_breaking_attention(x, w_qkv, w_o):
    B, T, D = x.shape
    H, Dh = SB_HEADS, SB_HEAD
    qkv = (x @ w_qkv).reshape(B, T, 3, H, Dh)
    q, k, v = qkv[:, :, 0], qkv[:, :, 1], qkv[:, :, 2]
    scale = Dh ** -0.5
    n_blocks = -(-T // Q_BLOCK)
    outs = []
    for blk in range(n_blocks):
        t0 = blk * Q_BLOCK
        t1 = min(T, t0 + Q_BLOCK)
        kb, vb = k[:, :t1], v[:, :t1]
        z = jnp.einsum('bqhd,bkhd->bhqk', q[:, t0:t1], kb).astype(jnp.float32) * scale
        causal = jnp.arange(t1)[None, :] < jnp.arange(t0, t1)[:, None]
        log_keep = jnp.where(causal, jax.nn.log_sigmoid(-z), 0.0)
        suffix = lax.cumsum(log_keep, axis=3, reverse=True) - log_keep
        attn = jnp.where(causal, jnp.exp(jax.nn.log_sigmoid(z) + suffix), 0.0)
        outs.append(jnp.einsum('bhqk,bkhd->bqhd', attn.astype(v.dtype), vb))
    o = jnp.concatenate(outs, axis=1).reshape(B, T, D)
    return o @ w_o


def squared_relu_mlp(x, w_up, w_down):
    return jnp.square(jax.nn.relu(x @ w_up)) @ w_down


def setup_inputs(seed: int = 0) -> dict:
    key = jax.random.key(seed)
    ks = jax.random.split(key, 32)
    D, R, S = D_MODEL, N_RWKV_LAYERS, N_SB_LAYERS
    nrm = jax.random.normal
    uni = jax.random.uniform
    f32 = jnp.float32
    return {
        'x': nrm(ks[0], (BATCH, SEQ, D), f32),
        'meta_tokens': nrm(ks[1], (N_META, D), f32),
        'ln_mix_g': 1.0 + 0.02 * nrm(ks[2], (DEPTH, D), f32),
        'ln_mix_b': 0.02 * nrm(ks[3], (DEPTH, D), f32),
        'ln_ffn_g': 1.0 + 0.02 * nrm(ks[4], (DEPTH, D), f32),
        'ln_ffn_b': 0.02 * nrm(ks[5], (DEPTH, D), f32),
        'w_up': nrm(ks[6], (DEPTH, D, D_FF), f32) * D ** -0.5,
        'w_down': nrm(ks[7], (DEPTH, D_FF, D), f32) * (DEEPNORM_BETA * D_FF ** -0.5),
        'rwkv_mu': uni(ks[8], (R, N_MU, D), f32),
        'rwkv_w_rkv': nrm(ks[9], (R, 3, D, D), f32) * D ** -0.5,
        'rwkv_w0': -6.0 + 5.0 * uni(ks[10], (R, D), f32),
        'rwkv_w1': nrm(ks[11], (R, D, D_DECAY_LORA), f32) * D ** -0.5,
        'rwkv_w2': nrm(ks[12], (R, D_DECAY_LORA, D), f32) * (0.5 * D_DECAY_LORA ** -0.5),
        'rwkv_a0': 0.1 * nrm(ks[13], (R, D), f32),
        'rwkv_a1': nrm(ks[14], (R, D, D_AAA_LORA), f32) * D ** -0.5,
        'rwkv_a2': nrm(ks[15], (R, D_AAA_LORA, D), f32) * (0.5 * D_AAA_LORA ** -0.5),
        'rwkv_g1': nrm(ks[16], (R, D, D_GATE_LORA), f32) * D ** -0.5,
        'rwkv_g2': nrm(ks[17], (R, D_GATE_LORA, D), f32) * D_GATE_LORA ** -0.5,
        'rwkv_k_k': 0.85 + 0.05 * nrm(ks[18], (R, D), f32),
        'rwkv_k_a': 1.0 + 0.05 * nrm(ks[19], (R, D), f32),
        'rwkv_r_k': 0.1 * nrm(ks[20], (R, RWKV_HEADS, RWKV_HEAD), f32),
        'rwkv_gn_g': 1.0 + 0.02 * nrm(ks[21], (R, D), f32),
        'rwkv_gn_b': 0.02 * nrm(ks[22], (R, D), f32),
        'rwkv_w_o': nrm(ks[23], (R, D, D), f32) * (DEEPNORM_BETA * D ** -0.5),
        'sb_w_qkv': nrm(ks[24], (S, D, 3 * D), f32) * D ** -0.5,
        'sb_w_o': nrm(ks[25], (S, D, D), f32) * (DEEPNORM_BETA * D ** -0.5),
    }


def reference(x, meta_tokens, ln_mix_g, ln_mix_b, ln_ffn_g, ln_ffn_b, w_up, w_down,
              rwkv_mu, rwkv_w_rkv, rwkv_w0, rwkv_w1, rwkv_w2, rwkv_a0, rwkv_a1, rwkv_a2,
              rwkv_g1, rwkv_g2, rwkv_k_k, rwkv_k_a, rwkv_r_k, rwkv_gn_g, rwkv_gn_b, rwkv_w_o,
              sb_w_qkv, sb_w_o):
    B = x.shape[0]
    meta = jnp.broadcast_to(meta_tokens[None].astype(x.dtype), (B, N_META, D_MODEL))
    h = jnp.concatenate([meta, x], axis=1)
    for i in range(DEPTH):
        j = i // N_MIXERS
        if i % N_MIXERS == 0:
            mix = rwkv7_time_mix(h, rwkv_mu[j], rwkv_w_rkv[j], rwkv_w0[j], rwkv_w1[j], rwkv_w2[j],
                                 rwkv_a0[j], rwkv_a1[j], rwkv_a2[j], rwkv_g1[j], rwkv_g2[j],
                                 rwkv_k_k[j], rwkv_k_a[j], rwkv_r_k[j], rwkv_gn_g[j], rwkv_gn_b[j],
                                 rwkv_w_o[j])
        else:
            mix = stick_breaking_attention(h, sb_w_qkv[j], sb_w_o[j])
        h = layer_norm(DEEPNORM_ALPHA * h + mix, ln_mix_g[i], ln_mix_b[i])
        h = layer_norm(DEEPNORM_ALPHA * h + squared_relu_mlp(h, w_up[i], w_down[i]),
                       ln_ffn_g[i], ln_ffn_b[i])
    return h[:, N_META:]
```

```cpp
#include <hip/hip_runtime.h>
#include <cstdio>
#include <cstdint>

#define LAS __attribute__((address_space(3)))
#define GAS __attribute__((address_space(1)))
typedef unsigned short bf16_t;
typedef short bf16x8 __attribute__((ext_vector_type(8)));
typedef float f32x2 __attribute__((ext_vector_type(2)));
typedef float f32x4 __attribute__((ext_vector_type(4)));
typedef float f32x16 __attribute__((ext_vector_type(16)));
typedef unsigned u32x2 __attribute__((ext_vector_type(2)));
typedef unsigned u32x4 __attribute__((ext_vector_type(4)));
typedef __bf16 bf16v2 __attribute__((ext_vector_type(2)));

__device__ __forceinline__ unsigned pk2(float lo, float hi) { f32x2 v = {lo, hi}; return __builtin_bit_cast(unsigned, __builtin_convertvector(v, bf16v2)); }
__device__ __forceinline__ float bf_lo(unsigned u) { return __builtin_bit_cast(float, u << 16); }
__device__ __forceinline__ float bf_hi(unsigned u) { return __builtin_bit_cast(float, u & 0xffff0000u); }
__device__ __forceinline__ float fexp2(float x) { return __builtin_amdgcn_exp2f(x); }
__device__ __forceinline__ float flog2(float x) { return __builtin_amdgcn_logf(x); }
__device__ __forceinline__ float fexp(float x) { return __builtin_amdgcn_exp2f(x * 1.44269504089f); }
__device__ __forceinline__ float frcp(float x) { return __builtin_amdgcn_rcpf(x); }
__device__ __forceinline__ float fsigmoid(float x) { return frcp(1.0f + fexp(-x)); }

constexpr int D = 4096, NBATCH = 4, TSEQ = 2048, NMETA = 16, FF = 16384;
constexpr int MREAL = NBATCH * TSEQ;
constexpr int MROWS = MREAL + NMETA;
constexpr int RP = 8448;
constexpr int RW_H = 64, RW_N = 64;
constexpr int SB_H = 32, SB_D = 128;
constexpr float LN_EPS = 1e-5f, GN_EPS = 64e-5f;
constexpr float DN_ALPHA = 1.4142135623730951f;
constexpr float QSCALE = 0.08838834764831845f * 1.4426950408889634f;

namespace pg8 {
constexpr int BM = 256, BK = 64, HALF = 128, HTB = HALF * BK * 2, STAGE_BYTES = 8 * HTB, NXCD = 8, WGM = 8;
__host__ __device__ __forceinline__ int lds_byte(int r, int c) { const int st = (r >> 4) * 2 + (c >> 5), rr = r & 15, cc = c & 31, ob = rr * 64 + cc * 2; return st * 1024 + (ob ^ (((ob >> 9) & 1) << 5)); }
__host__ __device__ __forceinline__ void stage_rc(int b, int& R, int& C) { const int st = b / 1024, sb = b % 1024, swz = sb ^ (((sb >> 9) & 1) << 5); R = (st >> 1) * 16 + swz / 64; C = (st & 1) * 32 + (swz % 64) / 2; }
__host__ __device__ __forceinline__ int perm32(int rho) { const int n = rho >> 4, i = rho & 15; return 8 * (i >> 2) + 4 * n + (i & 3); }

struct Unit { int pm, pn; };
struct TileOrder {
    int nM, nN, nwg, G, c;
    __device__ __forceinline__ void init(int nM_, int nN_, int G_, int c_) { nM = nM_; nN = nN_; nwg = nM * nN; G = G_; c = c_; }
    __device__ __forceinline__ bool next(int i, Unit& u) const {
        const long L = (long)i * G + c; if (L >= nwg) return false;
        int wgid = (int)L; { const int q = nwg / NXCD, r = nwg % NXCD, xcd = wgid % NXCD, off = wgid / NXCD; wgid = (xcd < r ? xcd * (q + 1) : r * (q + 1) + (xcd - r) * q) + off; }
        const int nig = WGM * nN, gid = wgid / nig, fm = gid * WGM, gsz = (nM - fm) < WGM ? (nM - fm) : WGM;
        u.pm = fm + ((wgid % nig) % gsz); u.pn = (wgid % nig) / gsz; return true;
    }
};

template <class Prob, class Epi, bool ALIGN_EPI, bool SP2>
__device__ __forceinline__ void gemm_phase(LAS unsigned char* lds, const Prob& P, const Epi& E) {
    const int tid = threadIdx.x, wid = __builtin_amdgcn_readfirstlane(tid >> 6), lane = tid & 63, wr = wid >> 2, wc = wid & 3, fr = lane & 15, fq = lane >> 4;
    const int K = P.K, nt = K / BK;
    unsigned voffA[2], voffB[2];
#pragma unroll
    for (int i = 0; i < 2; ++i) { int R, C; stage_rc(tid * 16 + i * 8192, R, C); const int Rb = Epi::PERM ? ((R & ~31) + perm32(R & 31)) : R;
        voffA[i] = (unsigned)(R * K + C) * 2u; voffB[i] = (unsigned)(Rb * K + C) * 2u; }
    const size_t kstep = (size_t)(BK * 2);
    const size_t hstep = (size_t)HALF * K * 2;
    const unsigned ldsw = (unsigned)wid * 1024u;
    const int aoff = lds_byte(wr * 64 + fr, fq * 8), boff = lds_byte(wc * 32 + fr, fq * 8);
#define PG8_SA(b, h) (((b) * 2 + (h)) * HTB)
#define PG8_SB(b, h) ((4 + (b) * 2 + (h)) * HTB)
#define PG8_STAGE(bufoff, gbase, voff) do { _Pragma("unroll") for (int _i = 0; _i < 2; ++_i) \
        __builtin_amdgcn_global_load_lds((const unsigned*)((const char*)(gbase) + (voff)[_i]), (LAS unsigned*)(lds + (bufoff) + ldsw + _i * 8192), 16, 0, 0); } while (0)
#define PG8_LDA(dst, b, h) do { _Pragma("unroll") for (int m = 0; m < 4; ++m) _Pragma("unroll") for (int k = 0; k < 2; ++k) dst[m][k] = *(const LAS bf16x8*)(lds + PG8_SA(b, h) + aoff + m * 2048 + k * 1024); } while (0)
#define PG8_LDB(dst, b, h) do { _Pragma("unroll") for (int n = 0; n < 2; ++n) _Pragma("unroll") for (int k = 0; k < 2; ++k) dst[n][k] = *(const LAS bf16x8*)(lds + PG8_SB(b, h) + boff + n * 2048 + k * 1024); } while (0)
#define PG8_MMA(ai, bj, At, Bt) do { __builtin_amdgcn_s_setprio(1); _Pragma("unroll") for (int m = 0; m < 4; ++m) _Pragma("unroll") for (int n = 0; n < 2; ++n) _Pragma("unroll") for (int k = 0; k < 2; ++k) \
        acc[ai][bj][m][n] = __builtin_amdgcn_mfma_f32_16x16x32_bf16(Bt[n][k], At[m][k], acc[ai][bj][m][n], 0, 0, 0); __builtin_amdgcn_s_setprio(0); } while (0)
#define PG8_WAIT_V(n) asm volatile("s_waitcnt vmcnt(" #n ")" ::: "memory")
#define PG8_WAIT_L(n) asm volatile("s_waitcnt lgkmcnt(" #n ")" ::: "memory")
#define PG8_BAR __builtin_amdgcn_s_barrier()
#define PG8_SCHED __builtin_amdgcn_sched_barrier(0)
    Unit cur, nxt; int ui = 0;
    if (!P.S.next(0, cur)) return;
    f32x4 acc[2][2][4][2];
#pragma unroll
    for (int a = 0; a < 2; ++a)
#pragma unroll
        for (int b = 0; b < 2; ++b)
#pragma unroll
            for (int m = 0; m < 4; ++m)
#pragma unroll
                for (int n = 0; n < 2; ++n) acc[a][b][m][n] = (f32x4){0.f, 0.f, 0.f, 0.f};
    bf16x8 At[4][2], B0[2][2], B1[2][2];
    const char* cA = P.a_base(cur); const char* cB = P.b_base(cur);
    if constexpr (SP2) {
        PG8_STAGE(PG8_SB(0, 0), cB, voffB); PG8_STAGE(PG8_SB(0, 1), cB + hstep, voffB); PG8_STAGE(PG8_SA(0, 0), cA, voffA); PG8_STAGE(PG8_SA(0, 1), cA + hstep, voffA);
        if (wr == 1) PG8_BAR;
        PG8_WAIT_V(2); PG8_BAR;
        PG8_STAGE(PG8_SB(1, 0), cB + kstep, voffB); PG8_STAGE(PG8_SA(1, 0), cA + kstep, voffA); PG8_STAGE(PG8_SB(1, 1), cB + hstep + kstep, voffB);
        PG8_WAIT_V(6); PG8_BAR;
    } else {
        PG8_STAGE(PG8_SB(0, 0), cB, voffB); PG8_STAGE(PG8_SA(0, 0), cA, voffA); PG8_STAGE(PG8_SB(0, 1), cB + hstep, voffB); PG8_STAGE(PG8_SA(0, 1), cA + hstep, voffA);
        if (wr == 1) PG8_BAR;
        PG8_WAIT_V(4); PG8_BAR;
        PG8_STAGE(PG8_SB(1, 0), cB + kstep, voffB); PG8_STAGE(PG8_SA(1, 0), cA + kstep, voffA); PG8_STAGE(PG8_SB(1, 1), cB + hstep + kstep, voffB);
        PG8_WAIT_V(6); PG8_BAR;
    }
    for (;;) {
        const bool has_next = P.S.next(ui + 1, nxt);
        const char* nA = has_next ? P.a_base(nxt) : cA; const char* nB = has_next ? P.b_base(nxt) : cB;
        for (int t = 0; t < nt; t += 2) {
            const bool last = (t == nt - 2);
            const char* a1 = cA + (size_t)(t + 1) * kstep;
            const char* a2 = last ? nA : cA + (size_t)(t + 2) * kstep; const char* b2 = last ? nB : cB + (size_t)(t + 2) * kstep;
            const char* a3 = a2 + kstep; const char* b3 = b2 + kstep;
            if constexpr (SP2) {
            PG8_LDB(B0, 0, 0); PG8_LDB(B1, 0, 1); PG8_SCHED; PG8_LDA(At, 0, 0); PG8_STAGE(PG8_SA(1, 1), a1 + hstep, voffA);
            PG8_WAIT_V(8); PG8_WAIT_L(0); PG8_BAR; PG8_MMA(0, 0, At, B0); PG8_MMA(0, 1, At, B1); PG8_BAR; PG8_SCHED;
            PG8_LDA(At, 0, 1); PG8_STAGE(PG8_SB(0, 0), b2, voffB); PG8_STAGE(PG8_SB(0, 1), b2 + hstep, voffB); PG8_STAGE(PG8_SA(0, 0), a2, voffA);
            PG8_WAIT_V(8); PG8_WAIT_L(0); PG8_BAR; PG8_MMA(1, 0, At, B0); PG8_MMA(1, 1, At, B1); PG8_BAR; PG8_SCHED;
            PG8_LDB(B0, 1, 0); PG8_LDB(B1, 1, 1); PG8_SCHED; PG8_LDA(At, 1, 0); PG8_STAGE(PG8_SA(0, 1), a2 + hstep, voffA);
            PG8_WAIT_V(8); PG8_WAIT_L(0); PG8_BAR; PG8_MMA(0, 0, At, B0); PG8_MMA(0, 1, At, B1); PG8_BAR; PG8_SCHED;
            PG8_LDA(At, 1, 1); PG8_STAGE(PG8_SB(1, 0), b3, voffB); PG8_STAGE(PG8_SB(1, 1), b3 + hstep, voffB); PG8_STAGE(PG8_SA(1, 0), a3, voffA);
            PG8_WAIT_V(8); PG8_WAIT_L(0); PG8_BAR; PG8_MMA(1, 0, At, B0); PG8_MMA(1, 1, At, B1); PG8_BAR; PG8_SCHED;
            } else {
            PG8_LDB(B0, 0, 0); PG8_SCHED; PG8_LDA(At, 0, 0); PG8_STAGE(PG8_SA(1, 1), a1 + hstep, voffA);
            PG8_WAIT_L(8); PG8_BAR; PG8_WAIT_L(0); PG8_MMA(0, 0, At, B0); PG8_BAR; PG8_SCHED;
            PG8_LDB(B1, 0, 1); PG8_STAGE(PG8_SB(0, 0), b2, voffB);
            PG8_BAR; PG8_WAIT_L(0); PG8_MMA(0, 1, At, B1); PG8_BAR;
            PG8_LDA(At, 0, 1); PG8_STAGE(PG8_SA(0, 0), a2, voffA);
            PG8_BAR; PG8_WAIT_L(0); PG8_MMA(1, 0, At, B0); PG8_BAR; PG8_SCHED;
            PG8_STAGE(PG8_SB(0, 1), b2 + hstep, voffB);
            PG8_WAIT_V(6); PG8_BAR; PG8_MMA(1, 1, At, B1); PG8_BAR;
            PG8_LDB(B0, 1, 0); PG8_SCHED; PG8_LDA(At, 1, 0); PG8_STAGE(PG8_SA(0, 1), a2 + hstep, voffA);
            PG8_WAIT_L(8); PG8_BAR; PG8_WAIT_L(0); PG8_MMA(0, 0, At, B0); PG8_BAR; PG8_SCHED;
            PG8_LDB(B1, 1, 1); PG8_STAGE(PG8_SB(1, 0), b3, voffB);
            PG8_BAR; PG8_WAIT_L(0); PG8_MMA(0, 1, At, B1); PG8_BAR;
            PG8_LDA(At, 1, 1); PG8_STAGE(PG8_SA(1, 0), a3, voffA);
            PG8_BAR; PG8_WAIT_L(0); PG8_MMA(1, 0, At, B0); PG8_BAR; PG8_SCHED;
            PG8_STAGE(PG8_SB(1, 1), b3 + hstep, voffB);
            PG8_WAIT_V(6); PG8_BAR; PG8_MMA(1, 1, At, B1); PG8_BAR;
            }
        }
        if constexpr (ALIGN_EPI) { if (wr == 0) PG8_BAR; }
        E(acc, cur, wr, wc, fr, fq);
        if (!has_next) break;
#pragma unroll
        for (int a = 0; a < 2; ++a)
#pragma unroll
            for (int b = 0; b < 2; ++b)
#pragma unroll
                for (int m = 0; m < 4; ++m)
#pragma unroll
                    for (int n = 0; n < 2; ++n) acc[a][b][m][n] = (f32x4){0.f, 0.f, 0.f, 0.f};
        cur = nxt; cA = nA; cB = nB; ++ui;
        if constexpr (ALIGN_EPI) { if (wr == 1) PG8_BAR; }
    }
    PG8_WAIT_V(0);
    if constexpr (!ALIGN_EPI) { if (wr == 0) PG8_BAR; }
    PG8_BAR;
#undef PG8_SA
#undef PG8_SB
#undef PG8_STAGE
#undef PG8_LDA
#undef PG8_LDB
#undef PG8_MMA
#undef PG8_WAIT_V
#undef PG8_WAIT_L
#undef PG8_BAR
#undef PG8_SCHED
}
}
using pg8::Unit;

constexpr size_t MiB = (size_t)1 << 20;
constexpr size_t WS_CTL = 0, CTL_ZERO_BYTES = 1 * MiB;
constexpr size_t WS_W = 1 * MiB;
constexpr size_t W0_CAT = WS_W;
constexpr size_t W0_L2 = W0_CAT + 104 * MiB;
constexpr size_t W0_O = W0_L2 + 12 * MiB;
constexpr size_t W0_UP = W0_O + 32 * MiB;
constexpr size_t W0_DN = W0_UP + 128 * MiB;
constexpr size_t W1_QKV = WS_W;
constexpr size_t W1_O = W1_QKV + 96 * MiB;
constexpr size_t W1_UP = W1_O + 32 * MiB;
constexpr size_t W1_DN = W1_UP + 128 * MiB;
constexpr size_t WS_X = WS_W + 404 * MiB;
constexpr size_t ACT_BF = (size_t)RP * D * 2;
constexpr size_t ACT_F32 = (size_t)RP * D * 4;
constexpr size_t WS_Y = WS_X + 396 * MiB;
constexpr size_t WS_ZB = WS_Y, WS_HF = WS_Y + 132 * MiB, WS_HB = WS_Y + 264 * MiB;
constexpr size_t WS_Z = WS_Y + 396 * MiB;
constexpr size_t WS_L1O = WS_Z;
constexpr size_t L1O_BYTES = (size_t)3 * RP * 512 * 2;
constexpr size_t WS_WDEC = WS_Z + 25 * MiB, WS_AA = WS_WDEC + 132 * MiB, WS_GG = WS_AA + 132 * MiB, WS_YG = WS_GG + 66 * MiB;
constexpr size_t WS_QB = WS_Z, WS_KB = WS_Z + 66 * MiB, WS_VB = WS_Z + 132 * MiB, WS_OB = WS_Z + 198 * MiB;
constexpr size_t WS_END = WS_Z + 421 * MiB;
static_assert(L1O_BYTES <= 25 * MiB && WS_YG + ACT_BF <= WS_END && W0_DN + 128 * MiB <= WS_X && 6 * ACT_BF <= 396 * MiB && 3 * ACT_F32 <= 396 * MiB, "ws map");
constexpr int CW_TMO = 0;
constexpr int CW_BAR = 4096;

constexpr int NWAVES = 8;
constexpr int RING_BYTES = 131072;
constexpr int LDSCTL_OFF = RING_BYTES, MISC_OFF = LDSCTL_OFF + 320;
constexpr int LDS_BYTES = 147456;

#define XB_TMO      128
#define XB_XCNT(j)  (256  + 64 * (j))
#define XB_XSUB(j)  (1280 + 64 * (j))
#define XB_XGEN(j)  (2304 + 64 * (j))
#define XB_TOP      3328
#define XB_TOPGEN   3392
#define XCD_BAR_WORDS 3456
#define XB_SPIN_CAP (1u << 18)
__device__ __forceinline__ unsigned xb_ld(unsigned* p)              { return __hip_atomic_load(p, __ATOMIC_RELAXED, __HIP_MEMORY_SCOPE_AGENT); }
__device__ __forceinline__ unsigned xb_add(unsigned* p, unsigned v) { return __hip_atomic_fetch_add(p, v, __ATOMIC_RELAXED, __HIP_MEMORY_SCOPE_AGENT); }
__device__ __forceinline__ unsigned xb_xcc_id() { return (unsigned)__builtin_amdgcn_s_getreg((3 << 11) | 20) & 0xFu; }
#define XB_SPIN(cond, bar) do { unsigned _sp = 0; while (cond) { __builtin_amdgcn_s_sleep(1); \
    if ((++_sp & 255u) == 0u) { if (xb_ld(&(bar)[XB_TMO])) break; if (_sp > XB_SPIN_CAP) { atomicAdd(&(bar)[XB_TMO], 1u); break; } } } } while (0)
struct XcdBarrier { unsigned* bar; unsigned x; volatile LAS unsigned* st; };
__device__ __forceinline__ XcdBarrier xcd_barrier_post(unsigned* bar, volatile LAS unsigned* st) {
    XcdBarrier b; b.bar = bar; b.x = xb_xcc_id(); b.st = st;
    if (threadIdx.x == 0) (void)xb_add(&bar[XB_XCNT(b.x)], 1u);
    return b;
}
__device__ __forceinline__ void xcd_barrier_complete(unsigned* bar, unsigned x, unsigned& nloc, unsigned& nx) {
    const unsigned G = gridDim.x * gridDim.y * gridDim.z;
    unsigned sum, cnt, mine, sp = 0u;
    for (;;) {
        sum = 0u; cnt = 0u; mine = 0u;
#pragma unroll
        for (unsigned j = 0; j < 16; ++j) { const unsigned c = xb_ld(&bar[XB_XCNT(j)]); sum += c; cnt += (c > 0u) ? 1u : 0u; mine = (j == x) ? c : mine; }
        if (sum == G) break;
        __builtin_amdgcn_s_sleep(1);
        if ((++sp & 255u) == 0u) { if (xb_ld(&bar[XB_TMO])) break; if (sp > XB_SPIN_CAP) { atomicAdd(&bar[XB_TMO], 1u); break; } }
    }
    nloc = mine > 0u ? mine : 1u; nx = cnt > 0u ? cnt : 1u;
}
__device__ __forceinline__ void xcd_barrier(const XcdBarrier& b) {
    asm volatile("s_waitcnt vmcnt(0)" ::: "memory");
    __syncthreads();
    if (threadIdx.x == 0) {
        unsigned* bar = b.bar;
        __builtin_amdgcn_s_waitcnt(0);
        unsigned nloc = b.st[0], nx = b.st[1];
        if (nloc == 0u) { xcd_barrier_complete(bar, b.x, nloc, nx); b.st[0] = nloc; b.st[1] = nx; }
        const unsigned old = xb_add(&bar[XB_XSUB(b.x)], 1u);
        const unsigned gen = old / nloc;
        if (old + 1u == (gen + 1u) * nloc) {
            __builtin_amdgcn_fence(__ATOMIC_RELEASE, "agent");
            asm volatile("s_waitcnt vmcnt(0)" ::: "memory");
            const unsigned og = xb_add(&bar[XB_TOP], 1u);
            const unsigned tg = og / nx;
            if (og + 1u == (tg + 1u) * nx) xb_add(&bar[XB_TOPGEN], 1u);
            else XB_SPIN(xb_ld(&bar[XB_TOPGEN]) == tg, bar);
            __builtin_amdgcn_fence(__ATOMIC_ACQUIRE, "agent");
            xb_add(&bar[XB_XGEN(b.x)], 1u);
            asm volatile("s_waitcnt vmcnt(0)" ::: "memory");
        } else {
            XB_SPIN(xb_ld(&bar[XB_XGEN(b.x)]) == gen, bar);
            __builtin_amdgcn_fence(__ATOMIC_ACQUIRE, "agent");
            asm volatile("s_waitcnt vmcnt(0)" ::: "memory");
        }
    }
    __syncthreads();
}

struct Params { const float* in[26]; float* out; unsigned char* ws; int ph_lo, ph_hi; };
enum { I_X = 0, I_META, I_LNMG, I_LNMB, I_LNFG, I_LNFB, I_WUP, I_WDN, I_MU, I_WRKV, I_W0, I_W1, I_W2, I_A0, I_A1, I_A2, I_G1, I_G2, I_KK, I_KA, I_RK, I_GNG, I_GNB, I_RWO, I_SBQKV, I_SBO };

struct Frame {
    LAS unsigned char* lds;
    int tid, lane, wave, vcu, G;
};
__device__ __forceinline__ float red16(float x) {
    x += __builtin_bit_cast(float, __builtin_amdgcn_update_dpp(0, __builtin_bit_cast(int, x), 0xB1, 0xF, 0xF, true));
    x += __builtin_bit_cast(float, __builtin_amdgcn_update_dpp(0, __builtin_bit_cast(int, x), 0x4E, 0xF, 0xF, true));
    x += __builtin_bit_cast(float, __builtin_amdgcn_update_dpp(0, __builtin_bit_cast(int, x), 0x141, 0xF, 0xF, true));
    x += __builtin_bit_cast(float, __builtin_amdgcn_update_dpp(0, __builtin_bit_cast(int, x), 0x140, 0xF, 0xF, true));
    return x;
}
__device__ __forceinline__ float wave_sum(float v) {
#pragma unroll
    for (int o = 1; o < 64; o <<= 1) v += __shfl_xor(v, o);
    return v;
}

struct ProbP1 {
    int K; pg8::TileOrder S; const char* mixed; const char* wcat;
    __device__ __forceinline__ const char* a_base(const Unit& u) const { const int gi = u.pn < 48 ? (u.pn >> 4) : (u.pn == 48 ? 3 : (u.pn == 49 ? 4 : 5)); return mixed + (size_t)gi * ACT_BF + (size_t)u.pm * 256 * D * 2; }
    __device__ __forceinline__ const char* b_base(const Unit& u) const { return wcat + (size_t)u.pn * 256 * D * 2; }
};
struct EpiP1 {
    static constexpr bool PERM = false;
    float* rkv; bf16_t* l1o;
    __device__ __forceinline__ void operator()(const f32x4 (&acc)[2][2][4][2], const Unit& u, int wr, int wc, int fr, int fq) const {
        const int row0 = u.pm * 256 + wr * 64 + fr, c0 = wc * 32 + 4 * fq;
        if (u.pn < 48) {
            float* C = rkv + (size_t)(u.pn >> 4) * RP * D + (u.pn & 15) * 256 + c0;
#pragma unroll
            for (int ai = 0; ai < 2; ++ai)
#pragma unroll
                for (int m = 0; m < 4; ++m) { float* rowp = C + (size_t)(row0 + ai * 128 + m * 16) * D;
#pragma unroll
                    for (int bj = 0; bj < 2; ++bj)
#pragma unroll
                        for (int n = 0; n < 2; ++n) *(f32x4*)(rowp + bj * 128 + n * 16) = acc[ai][bj][m][n]; }
        } else {
            const int lt = u.pn - 48, sub = lt < 2 ? lt : 2;
            bf16_t* O = l1o + (size_t)sub * RP * 512 + (lt == 3 ? 256 : 0) + c0;
#pragma unroll
            for (int ai = 0; ai < 2; ++ai)
#pragma unroll
                for (int m = 0; m < 4; ++m) { bf16_t* rowp = O + (size_t)(row0 + ai * 128 + m * 16) * 512;
#pragma unroll
                    for (int bj = 0; bj < 2; ++bj)
#pragma unroll
                        for (int n = 0; n < 2; ++n) { f32x4 v = acc[ai][bj][m][n];
                            if (sub == 0) {
#pragma unroll
                                for (int j = 0; j < 4; ++j) v[j] = 1.0f - 2.0f * frcp(fexp(2.0f * v[j]) + 1.0f);
                            } else if (sub == 2) {
#pragma unroll
                                for (int j = 0; j < 4; ++j) v[j] = fsigmoid(v[j]);
                            }
                            u32x2 w; w.x = pk2(v[0], v[1]); w.y = pk2(v[2], v[3]); *(u32x2*)(rowp + bj * 128 + n * 16) = w; } }
        }
    }
};
struct ProbL2 {
    int K; pg8::TileOrder S; const char* l1o; const char* w2;
    __device__ __forceinline__ const char* a_base(const Unit& u) const { return l1o + (size_t)(u.pn >> 4) * RP * 512 * 2 + (size_t)u.pm * 256 * 512 * 2; }
    __device__ __forceinline__ const char* b_base(const Unit& u) const { return w2 + (size_t)u.pn * 256 * 512 * 2; }
};
struct EpiL2 {
    static constexpr bool PERM = false;
    float* wdec; float* aa; bf16_t* gg; const float* w0; const float* a0;
    __device__ __forceinline__ void operator()(const f32x4 (&acc)[2][2][4][2], const Unit& u, int wr, int wc, int fr, int fq) const {
        const int row0 = u.pm * 256 + wr * 64 + fr, col0 = (u.pn & 15) * 256 + wc * 32 + 4 * fq, sub = u.pn >> 4;
#pragma unroll
        for (int bj = 0; bj < 2; ++bj)
#pragma unroll
            for (int n = 0; n < 2; ++n) { const int col = col0 + bj * 128 + n * 16;
                f32x4 bias = (f32x4){0.f, 0.f, 0.f, 0.f};
                if (sub == 0) bias = *(const f32x4*)(w0 + col); else if (sub == 1) bias = *(const f32x4*)(a0 + col);
#pragma unroll
                for (int ai = 0; ai < 2; ++ai)
#pragma unroll
                    for (int m = 0; m < 4; ++m) { const size_t off = (size_t)(row0 + ai * 128 + m * 16) * D + col;
                        f32x4 v = acc[ai][bj][m][n] + bias;
                        if (sub == 0) {
#pragma unroll
                            for (int j = 0; j < 4; ++j) v[j] = fexp(-0.60653065971f * fsigmoid(v[j]));
                            *(f32x4*)(wdec + off) = v;
                        } else if (sub == 1) {
#pragma unroll
                            for (int j = 0; j < 4; ++j) v[j] = fsigmoid(v[j]);
                            *(f32x4*)(aa + off) = v;
                        } else { u32x2 w; w.x = pk2(v[0], v[1]); w.y = pk2(v[2], v[3]); *(u32x2*)(gg + off) = w; } } }
    }
};
struct ProbG {
    int K; pg8::TileOrder S; const char* A; const char* Bt;
    __device__ __forceinline__ const char* a_base(const Unit& u) const { return A + (size_t)u.pm * 256 * K * 2; }
    __device__ __forceinline__ const char* b_base(const Unit& u) const { return Bt + (size_t)u.pn * 256 * K * 2; }
};
template <bool L0> struct EpiRes {
    static constexpr bool PERM = false;
    float* z; const float* res; const float* meta;
    __device__ __forceinline__ void operator()(const f32x4 (&acc)[2][2][4][2], const Unit& u, int wr, int wc, int fr, int fq) const {
        const int row0 = u.pm * 256 + wr * 64 + fr, col0 = u.pn * 256 + wc * 32 + 4 * fq;
#pragma unroll
        for (int ai = 0; ai < 2; ++ai)
#pragma unroll
            for (int m = 0; m < 4; ++m) { const int row = row0 + ai * 128 + m * 16;
                const float* rp;
                if (L0) { if (u.pm == 32) { if (row >= MROWS) continue; rp = meta + (size_t)(row - MREAL) * D + col0; } else rp = res + (size_t)row * D + col0; }
                else rp = res + (size_t)row * D + col0;
                float* zp = z + (size_t)row * D + col0;
#pragma unroll
                for (int bj = 0; bj < 2; ++bj)
#pragma unroll
                    for (int n = 0; n < 2; ++n) { const f32x4 r = *(const f32x4*)(rp + bj * 128 + n * 16); *(f32x4*)(zp + bj * 128 + n * 16) = r * DN_ALPHA + acc[ai][bj][m][n]; } }
    }
};
struct EpiUp {
    static constexpr bool PERM = true;
    bf16_t* O;
    __device__ __forceinline__ void operator()(const f32x4 (&acc)[2][2][4][2], const Unit& u, int wr, int wc, int fr, int fq) const {
        const int row0 = u.pm * 256 + wr * 64 + fr, col0 = u.pn * 256 + wc * 32 + 8 * fq;
#pragma unroll
        for (int ai = 0; ai < 2; ++ai)
#pragma unroll
            for (int m = 0; m < 4; ++m) { bf16_t* rowp = O + (size_t)(row0 + ai * 128 + m * 16) * FF + col0;
#pragma unroll
                for (int bj = 0; bj < 2; ++bj) { f32x4 v0 = acc[ai][bj][m][0], v1 = acc[ai][bj][m][1];
#pragma unroll
                    for (int j = 0; j < 4; ++j) { const float a = fmaxf(v0[j], 0.f), b = fmaxf(v1[j], 0.f); v0[j] = a * a; v1[j] = b * b; }
                    u32x4 w; w.x = pk2(v0[0], v0[1]); w.y = pk2(v0[2], v0[3]); w.z = pk2(v1[0], v1[1]); w.w = pk2(v1[2], v1[3]);
                    *(u32x4*)(rowp + bj * 128) = w; } }
    }
};
struct EpiQkv {
    static constexpr bool PERM = true;
    bf16_t* qb;
    __device__ __forceinline__ void operator()(const f32x4 (&acc)[2][2][4][2], const Unit& u, int wr, int wc, int fr, int fq) const {
        const int t = u.pn >> 4; const float sc = (t == 0) ? QSCALE : 1.0f;
        bf16_t* O = qb + (size_t)t * RP * D;
        const int row0 = u.pm * 256 + wr * 64 + fr, col0 = (u.pn & 15) * 256 + wc * 32 + 8 * fq;
#pragma unroll
        for (int ai = 0; ai < 2; ++ai)
#pragma unroll
            for (int m = 0; m < 4; ++m) { bf16_t* rowp = O + (size_t)(row0 + ai * 128 + m * 16) * D + col0;
#pragma unroll
                for (int bj = 0; bj < 2; ++bj) { const f32x4 v0 = acc[ai][bj][m][0] * sc, v1 = acc[ai][bj][m][1] * sc;
                    u32x4 w; w.x = pk2(v0[0], v0[1]); w.y = pk2(v0[2], v0[3]); w.z = pk2(v1[0], v1[1]); w.w = pk2(v1[2], v1[3]);
                    *(u32x4*)(rowp + bj * 128) = w; } }
    }
};

__device__ __forceinline__ void tr_item(const float* W, int K, int N, int nblk, bf16_t* WT, int Kp, LAS float* scr, int item, int lane) {
    const int kb = item / nblk, nb = item - kb * nblk, k0 = 64 * kb, n0 = 32 * nb;
    const int lr = lane >> 3, lc = (lane & 7) * 4;
    f32x4 v[8];
#pragma unroll
    for (int i = 0; i < 8; ++i) { const int k = k0 + lr + 8 * i, n = n0 + lc; v[i] = (k < K && n < N) ? *(const f32x4*)(W + (size_t)k * N + n) : (f32x4){0.f, 0.f, 0.f, 0.f}; }
#pragma unroll
    for (int i = 0; i < 8; ++i) { LAS float* s = scr + (lr + 8 * i) * 33 + lc; s[0] = v[i].x; s[1] = v[i].y; s[2] = v[i].z; s[3] = v[i].w; }
    asm volatile("s_waitcnt lgkmcnt(0)" ::: "memory");
    const int c = lane & 7;
#pragma unroll
    for (int j = 0; j < 4; ++j) { const int n = (lane >> 3) + 8 * j; const LAS float* s = scr + (8 * c) * 33 + n;
        u32x4 o; o.x = pk2(s[0], s[33]); o.y = pk2(s[66], s[99]); o.z = pk2(s[132], s[165]); o.w = pk2(s[198], s[231]);
        *(u32x4*)(WT + (size_t)(n0 + n) * Kp + k0 + 8 * c) = o; }
    asm volatile("s_waitcnt lgkmcnt(0)" ::: "memory");
}
struct TrJob { const float* W; int K, N, Kp, Np; bf16_t* WT; };
template <int NJ> __device__ __forceinline__ void tr_jobs(const Frame& F, const TrJob (&J)[NJ]) {
    LAS float* scr = (LAS float*)(F.lds + F.wave * 8448);
    const int gw = F.vcu * NWAVES + F.wave, NGW = F.G * NWAVES;
    int total = 0;
#pragma unroll
    for (int j = 0; j < NJ; ++j) total += (J[j].Kp / 64) * (J[j].Np / 32);
    for (int it = gw; it < total; it += NGW) {
        int r = it;
#pragma unroll
        for (int j = 0; j < NJ; ++j) { const int n = (J[j].Kp / 64) * (J[j].Np / 32);
            if (r >= 0 && r < n) tr_item(J[j].W, J[j].K, J[j].N, J[j].Np / 32, J[j].WT, J[j].Kp, scr, r, F.lane);
            r -= n; }
    }
}
__device__ __forceinline__ void mix_phase(const Frame& F, const float* x, const float* meta, const float* mu, bf16_t* mixed) {
    const int gw = F.vcu * NWAVES + F.wave, NGW = F.G * NWAVES;
    for (int task = gw; task < 16 * 257; task += NGW) {
        const int cc = task & 15, rr = task >> 4, col = cc * 256 + F.lane * 4;
        const int row0 = rr < 256 ? rr * 32 : MREAL, nrows = rr < 256 ? 32 : NMETA;
        f32x4 m4[6];
#pragma unroll
        for (int n = 0; n < 6; ++n) m4[n] = *(const f32x4*)(mu + (size_t)n * D + col);
        f32x4 prev = (f32x4){0.f, 0.f, 0.f, 0.f};
        if (rr < 256) prev = ((row0 & (TSEQ - 1)) == 0) ? *(const f32x4*)(meta + (size_t)(NMETA - 1) * D + col) : *(const f32x4*)(x + (size_t)(row0 - 1) * D + col);
        const float* src = rr < 256 ? x + (size_t)row0 * D + col : meta + col;
#pragma unroll 4
        for (int i = 0; i < nrows; ++i) {
            const f32x4 h = *(const f32x4*)(src + (size_t)i * D);
            const f32x4 xx = prev - h;
#pragma unroll
            for (int n = 0; n < 6; ++n) { const f32x4 m = h + xx * m4[n]; u32x2 w; w.x = pk2(m[0], m[1]); w.y = pk2(m[2], m[3]);
                *(u32x2*)(mixed + (size_t)n * RP * D + (size_t)(row0 + i) * D + col) = w; }
            prev = h;
        }
    }
}
__device__ __forceinline__ void zero_bytes(const Frame& F, unsigned char* p, size_t nbytes) {
    const size_t n16 = nbytes / 16, stride = (size_t)F.G * NWAVES * 64;
    for (size_t i = (size_t)(F.vcu * NWAVES + F.wave) * 64 + F.lane; i < n16; i += stride) ((u32x4*)p)[i] = (u32x4){0u, 0u, 0u, 0u};
}
__device__ __forceinline__ void ln_phase(const Frame& F, const float* z, const float* g, const float* b, float* hf, bf16_t* hb, int nrows) {
    const int gw = F.vcu * NWAVES + F.wave, NGW = F.G * NWAVES;
    for (int row = gw; row < nrows; row += NGW) {
        const f32x4* zr = (const f32x4*)(z + (size_t)row * D) + F.lane;
        f32x4 v[16]; float s = 0.f;
#pragma unroll
        for (int j = 0; j < 16; ++j) { v[j] = zr[64 * j]; s += (v[j].x + v[j].y) + (v[j].z + v[j].w); }
        const float mean = wave_sum(s) * (1.f / D); float s2 = 0.f;
#pragma unroll
        for (int j = 0; j < 16; ++j) { v[j] = v[j] - mean; s2 += (v[j].x * v[j].x + v[j].y * v[j].y) + (v[j].z * v[j].z + v[j].w * v[j].w); }
        const float rstd = 1.f / sqrtf(wave_sum(s2) * (1.f / D) + LN_EPS);
#pragma unroll
        for (int j = 0; j < 16; ++j) { const int col = (64 * j + F.lane) * 4;
            const f32x4 o = v[j] * rstd * *(const f32x4*)(g + col) + *(const f32x4*)(b + col);
            if (hf) *(f32x4*)(hf + (size_t)row * D + col) = o;
            if (hb) { u32x2 w; w.x = pk2(o[0], o[1]); w.y = pk2(o[2], o[3]); *(u32x2*)(hb + (size_t)row * D + col) = w; } }
    }
}

constexpr int SC_RDY = 0;
constexpr int SC_VB = SC_RDY + 32 * 5 * 64 * 4;
constexpr int SC_SCL = SC_VB + 32 * 64 * 4;
constexpr int SC_YB = SC_SCL + 32 * 2 * 4;
struct ScanArgs { const float* r; const float* k; const float* v; const float* w; const float* a; const bf16_t* g; bf16_t* yg;
                  const float* k_k; const float* k_a; const float* r_k; const float* gn_g; const float* gn_b; };
__device__ __forceinline__ void scan_phase(const Frame& F, const ScanArgs& A) {
    LAS float* RDY = (LAS float*)(F.lds + SC_RDY); LAS float* VB = (LAS float*)(F.lds + SC_VB); LAS float* SCL = (LAS float*)(F.lds + SC_SCL); LAS float* YB = (LAS float*)(F.lds + SC_YB);
    const int tid = F.tid, lane = F.lane, w = F.wave;
    const int tt = tid >> 4, j4 = (tid & 15) * 4;
    const int g4 = lane >> 4, q4 = (lane & 15) * 4, i0 = 8 * w + 2 * g4;
    for (int bh = blockIdx.x; bh < NBATCH * RW_H; bh += F.G) {
        const int b = bh >> 6, h = bh & 63, col = h * 64 + j4;
        const f32x4 ckk = *(const f32x4*)(A.k_k + col), cka = *(const f32x4*)(A.k_a + col), crk = *(const f32x4*)(A.r_k + col);
        const f32x4 cgg = *(const f32x4*)(A.gn_g + col), cgb = *(const f32x4*)(A.gn_b + col);
        float S0[4] = {0.f, 0.f, 0.f, 0.f}, S1[4] = {0.f, 0.f, 0.f, 0.f};
        f32x4 pr, pk, pv, pw, pa;
        {
            const size_t off = (size_t)(MREAL + (tt & 15)) * D + col;
            pr = *(const f32x4*)(A.r + off); pk = *(const f32x4*)(A.k + off); pv = *(const f32x4*)(A.v + off); pw = *(const f32x4*)(A.w + off); pa = *(const f32x4*)(A.a + off);
        }
        for (int c = 0; c <= 64; ++c) {
            const int nsteps = c == 0 ? NMETA : 32;
            const int rowbase = c == 0 ? MREAL : b * TSEQ + (c - 1) * 32;
            const bool act = tt < nsteps;
            const f32x4 kx = pk * ckk;
            const float ss = red16((kx[0] * kx[0] + kx[1] * kx[1]) + (kx[2] * kx[2] + kx[3] * kx[3]));
            const float inv = 1.0f / fmaxf(sqrtf(ss), 1e-12f);
            const f32x4 kk = kx * inv;
            const f32x4 kp = pk * ((pa - 1.0f) * cka + 1.0f);
            const f32x4 bb = -(kk * pa);
            const f32x4 wr4 = pw * pr;
            const float br = red16((bb[0] * pr[0] + bb[1] * pr[1]) + (bb[2] * pr[2] + bb[3] * pr[3]));
            const float kr = red16((kp[0] * pr[0] + kp[1] * pr[1]) + (kp[2] * pr[2] + kp[3] * pr[3]));
            const f32x4 rkk = pr * kp * crk;
            const float bonus = red16((rkk[0] + rkk[1]) + (rkk[2] + rkk[3]));
            const f32x4 vkeep = pv;
            if (act) {
                LAS float* rd = RDY + tt * 320 + j4;
                *(LAS f32x4*)(rd) = kk; *(LAS f32x4*)(rd + 64) = wr4; *(LAS f32x4*)(rd + 128) = pw; *(LAS f32x4*)(rd + 192) = bb; *(LAS f32x4*)(rd + 256) = kp;
                *(LAS f32x4*)(VB + tt * 64 + j4) = pv;
                if ((tid & 15) == 0) { SCL[tt * 2] = br; SCL[tt * 2 + 1] = kr; }
            }
            u32x2 pg = (u32x2){0u, 0u};
            if (act) pg = *(const u32x2*)(A.g + (size_t)(rowbase + tt) * D + col);
            if (c < 64) { const size_t off = (size_t)(b * TSEQ + c * 32 + tt) * D + col;
                pr = *(const f32x4*)(A.r + off); pk = *(const f32x4*)(A.k + off); pv = *(const f32x4*)(A.v + off); pw = *(const f32x4*)(A.w + off); pa = *(const f32x4*)(A.a + off); }
            __syncthreads();
#pragma unroll 2
            for (int s = 0; s < nsteps; ++s) {
                const LAS float* rd = RDY + s * 320 + q4;
                const f32x4 kk4 = *(const LAS f32x4*)(rd), wr = *(const LAS f32x4*)(rd + 64), w4 = *(const LAS f32x4*)(rd + 128), b4 = *(const LAS f32x4*)(rd + 192), kp4 = *(const LAS f32x4*)(rd + 256);
                const f32x2 v2 = *(const LAS f32x2*)(VB + s * 64 + i0);
                const f32x2 sc = *(const LAS f32x2*)(SCL + s * 2);
                float p0 = (S0[0] * kk4[0] + S0[1] * kk4[1]) + (S0[2] * kk4[2] + S0[3] * kk4[3]);
                float p1 = (S1[0] * kk4[0] + S1[1] * kk4[1]) + (S1[2] * kk4[2] + S1[3] * kk4[3]);
                float y0 = (S0[0] * wr[0] + S0[1] * wr[1]) + (S0[2] * wr[2] + S0[3] * wr[3]);
                float y1 = (S1[0] * wr[0] + S1[1] * wr[1]) + (S1[2] * wr[2] + S1[3] * wr[3]);
                p0 = red16(p0); p1 = red16(p1); y0 = red16(y0); y1 = red16(y1);
#pragma unroll
                for (int j = 0; j < 4; ++j) { S0[j] = S0[j] * w4[j] + (p0 * b4[j] + v2[0] * kp4[j]); S1[j] = S1[j] * w4[j] + (p1 * b4[j] + v2[1] * kp4[j]); }
                if ((lane & 15) == 0) { f32x2 yy; yy[0] = y0 + p0 * sc[0] + v2[0] * sc[1]; yy[1] = y1 + p1 * sc[0] + v2[1] * sc[1]; *(LAS f32x2*)(YB + s * 64 + i0) = yy; }
            }
            __syncthreads();
            if (act && (c > 0 || b == 0)) {
                const f32x4 y4 = *(const LAS f32x4*)(YB + tt * 64 + j4);
                const float mu = red16((y4[0] + y4[1]) + (y4[2] + y4[3])) * (1.0f / 64.0f);
                const f32x4 d = y4 - mu;
                const float var = red16((d[0] * d[0] + d[1] * d[1]) + (d[2] * d[2] + d[3] * d[3])) * (1.0f / 64.0f);
                const float rstd = 1.0f / sqrtf(var + GN_EPS);
                f32x4 o = d * rstd * cgg + cgb + vkeep * bonus;
                o[0] *= bf_lo(pg.x); o[1] *= bf_hi(pg.x); o[2] *= bf_lo(pg.y); o[3] *= bf_hi(pg.y);
                u32x2 wv; wv.x = pk2(o[0], o[1]); wv.y = pk2(o[2], o[3]);
                *(u32x2*)(A.yg + (size_t)(rowbase + tt) * D + col) = wv;
            }
        }
        __syncthreads();
    }
}

constexpr int AT_KT = 0;
constexpr int AT_VT = 32768;
constexpr int AT_QS = 65536;
#define MFMA32(a, b, c) __builtin_amdgcn_mfma_f32_32x32x16_bf16((a), (b), (c), 0, 0, 0)
__device__ __forceinline__ void attn_phase(const Frame& F, const bf16_t* qb, const bf16_t* kb, const bf16_t* vb, bf16_t* ob) {
    const int tid = F.tid, lane = F.lane, w = F.wave, c = lane & 31, h = lane >> 5;
    LAS unsigned char* KT = F.lds + AT_KT; LAS unsigned char* VT = F.lds + AT_VT;
    bf16x8 U[2];
#pragma unroll
    for (int s = 0; s < 2; ++s)
#pragma unroll
        for (int j = 0; j < 8; ++j) { const int kin = 16 * s + 8 * (j >> 2) + 4 * h + (j & 3); U[s][j] = kin > c ? (short)0xBF80 : (short)0; }
    for (int unit = blockIdx.x; unit < NBATCH * SB_H * 4; unit += F.G) {
        const int bh = unit >> 2, pr = unit & 3, b = bh >> 5, hh = bh & 31;
        for (int half = 0; half < 2; ++half) {
            const int Q0 = (half == 0 ? 7 - pr : pr) * 256, q0 = Q0 + 32 * w, diag = q0 >> 5;
            const size_t qrow = (size_t)b * TSEQ + q0 + c;
            LAS unsigned char* QS = F.lds + AT_QS + w * 8192 + c * 256;
#pragma unroll
            for (int ks = 0; ks < 8; ++ks) *(LAS bf16x8*)(QS + (((2 * ks + h) ^ (c & 15)) * 16)) = *(const bf16x8*)(qb + qrow * D + hh * SB_D + 16 * ks + 8 * h);
            f32x16 O[4];
#pragma unroll
            for (int dt = 0; dt < 4; ++dt)
#pragma unroll
                for (int i = 0; i < 16; ++i) O[dt][i] = 0.f;
            float carry = 0.f;
            const int nst = (Q0 >> 6) + 4;
            u32x4 kreg[2], vreg[2];
#define AT_PREFETCH(n_) do { const int n__ = (n_); _Pragma("unroll") for (int i = 0; i < 2; ++i) { const int idx = tid + 512 * i, key = idx >> 4, ch = idx & 15; \
                if (n__ < nst) { const size_t off = ((size_t)b * TSEQ + 64 * (nst - 1 - n__) + key) * D + hh * SB_D + ch * 8; kreg[i] = *(const u32x4*)(kb + off); vreg[i] = *(const u32x4*)(vb + off); } \
                else if (key < NMETA) { const size_t off = ((size_t)MREAL + key) * D + hh * SB_D + ch * 8; kreg[i] = *(const u32x4*)(kb + off); vreg[i] = *(const u32x4*)(vb + off); } \
                else { kreg[i] = (u32x4){0u, 0u, 0u, 0u}; vreg[i] = (u32x4){0u, 0u, 0u, 0u}; } } } while (0)
            AT_PREFETCH(0);
            for (int n = 0; n <= nst; ++n) {
                const int buf = n & 1;
#pragma unroll
                for (int i = 0; i < 2; ++i) { const int idx = tid + 512 * i, key = idx >> 4, ch = idx & 15;
                    *(LAS u32x4*)(KT + buf * 16384 + key * 256 + ((ch ^ (key & 15)) * 16)) = kreg[i];
#pragma unroll
                    for (int e = 0; e < 8; ++e) { const int d = ch * 8 + e; const unsigned wv = vreg[i][e >> 1]; const unsigned short val = (e & 1) ? (unsigned short)(wv >> 16) : (unsigned short)(wv & 0xffffu);
                        *(LAS unsigned short*)(VT + buf * 16384 + d * 128 + (((key >> 2) ^ ((d >> 1) & 15)) * 8) + (key & 3) * 2) = val; } }
                __syncthreads();
                if (n < nst) AT_PREFETCH(n + 1);
                const bool meta = (n == nst);
                const int ks_abs = nst - 1 - n;
#pragma nounroll
                for (int sb = 1; sb >= 0; --sb) {
                    int limit;
                    if (meta) { if (sb == 1) continue; limit = NMETA; }
                    else { const int st_abs = 2 * ks_abs + sb; if (st_abs > diag) continue; limit = (st_abs == diag) ? c : 64; }
                    const int key_l = 32 * sb + c;
                    f32x16 Z;
#pragma unroll
                    for (int i = 0; i < 16; ++i) Z[i] = 0.f;
#pragma unroll
                    for (int ks = 0; ks < 8; ++ks) { const bf16x8 a = *(const LAS bf16x8*)(KT + buf * 16384 + key_l * 256 + (((2 * ks + h) ^ (key_l & 15)) * 16)); const bf16x8 qf = *(const LAS bf16x8*)(QS + (((2 * ks + h) ^ (c & 15)) * 16)); Z = MFMA32(a, qf, Z); }
                    f32x16 X, Y;
#pragma unroll
                    for (int i = 0; i < 16; ++i) { const int row = (i & 3) + 8 * (i >> 2) + 4 * h; const float z = Z[i];
                        const float l2 = fmaxf(z, 0.f) + flog2(1.0f + fexp2(-fabsf(z)));
                        X[i] = row < limit ? l2 : 0.f; Y[i] = (z - X[i]) + carry; }
                    bf16x8 Xh[2], Xl[2];
#pragma unroll
                    for (int s = 0; s < 2; ++s) { u32x4 hu, lu;
#pragma unroll
                        for (int jj = 0; jj < 4; ++jj) { const float x0 = X[8 * s + 2 * jj], x1 = X[8 * s + 2 * jj + 1]; const unsigned hv = pk2(x0, x1); hu[jj] = hv; lu[jj] = pk2(x0 - bf_lo(hv), x1 - bf_hi(hv)); }
                        Xh[s] = __builtin_bit_cast(bf16x8, hu); Xl[s] = __builtin_bit_cast(bf16x8, lu); }
                    Y = MFMA32(U[0], Xh[0], Y); Y = MFMA32(U[1], Xh[1], Y); Y = MFMA32(U[0], Xl[0], Y); Y = MFMA32(U[1], Xl[1], Y);
                    carry = __shfl(Y[0] - Z[0], c);
                    bf16x8 Pb[2];
#pragma unroll
                    for (int s = 0; s < 2; ++s) { u32x4 pu;
#pragma unroll
                        for (int jj = 0; jj < 4; ++jj) { const int i0 = 8 * s + 2 * jj, i1 = i0 + 1; const int r0 = (i0 & 3) + 8 * (i0 >> 2) + 4 * h, r1 = (i1 & 3) + 8 * (i1 >> 2) + 4 * h;
                            const float p0 = r0 < limit ? fexp2(Y[i0]) : 0.f, p1 = r1 < limit ? fexp2(Y[i1]) : 0.f; pu[jj] = pk2(p0, p1); }
                        Pb[s] = __builtin_bit_cast(bf16x8, pu); }
#pragma unroll
                    for (int dt = 0; dt < 4; ++dt) { const int d = 32 * dt + c;
#pragma unroll
                        for (int s = 0; s < 2; ++s) { const int ch8 = 8 * sb + 4 * s + h;
                            const LAS unsigned char* rowp = VT + buf * 16384 + d * 128;
                            const u32x2 lo = *(const LAS u32x2*)(rowp + ((ch8 ^ ((d >> 1) & 15)) * 8)), hi = *(const LAS u32x2*)(rowp + (((ch8 + 2) ^ ((d >> 1) & 15)) * 8));
                            const u32x4 av = (u32x4){lo.x, lo.y, hi.x, hi.y};
                            O[dt] = MFMA32(__builtin_bit_cast(bf16x8, av), Pb[s], O[dt]); } }
                }
            }
#undef AT_PREFETCH
#pragma unroll
            for (int dt = 0; dt < 4; ++dt)
#pragma unroll
                for (int g = 0; g < 4; ++g) { u32x2 wv; wv.x = pk2(O[dt][4 * g], O[dt][4 * g + 1]); wv.y = pk2(O[dt][4 * g + 2], O[dt][4 * g + 3]);
                    *(u32x2*)(ob + qrow * D + hh * SB_D + 32 * dt + 8 * g + 4 * h) = wv; }
            __syncthreads();
        }
    }
}

constexpr int N_PHASES = 16;
#ifndef MK_ONE_LAUNCH
#define MK_ONE_LAUNCH 1
#endif
struct KArgs { const float* in[26]; float* out; unsigned char* ws; int ph_lo, ph_hi, li, pad; };

__global__ void __launch_bounds__(NWAVES * 64, 2) fwd_kernel(KArgs args) {
    extern __shared__ __attribute__((aligned(16))) unsigned char lds_raw[];
    Frame F;
    F.lds = (LAS unsigned char*)lds_raw;
    F.tid = threadIdx.x; F.lane = F.tid & 63; F.wave = __builtin_amdgcn_readfirstlane(F.tid >> 6);
    F.G = gridDim.x; { const int bx = blockIdx.x; F.vcu = (F.G % 8 == 0) ? (bx % 8) * (F.G / 8) + bx / 8 : bx; }
    volatile LAS unsigned* MISC = (volatile LAS unsigned*)(F.lds + MISC_OFF);
    for (int u = F.tid; u < (LDS_BYTES - LDSCTL_OFF) / 4; u += NWAVES * 64) ((LAS unsigned*)(F.lds + LDSCTL_OFF))[u] = 0u;
    __syncthreads();
    unsigned char* ws = args.ws;
    unsigned* ctl = (unsigned*)(ws + WS_CTL);
    const int lo = args.ph_lo, hi = args.ph_hi;
    XcdBarrier bar; bar.bar = ctl + CW_BAR + args.li * XCD_BAR_WORDS; bar.x = 0; bar.st = nullptr;
    if (hi - lo > 1) bar = xcd_barrier_post(ctl + CW_BAR + args.li * XCD_BAR_WORDS, MISC + 8);
#ifndef ONLY_PHASE
#define ONLY_PHASE -1
#endif
#define IN(k) ((ONLY_PHASE < 0 || ONLY_PHASE == (k)) && lo <= (k) && (k) < hi)
#define SEAM(k) do { if (IN(k) && IN((k) + 1)) xcd_barrier(bar); } while (0)
    const float* x = args.in[I_X]; const float* meta = args.in[I_META];
    LAS unsigned char* ring = F.lds;
    const int bid = (int)blockIdx.x;

    if (IN(0)) {
        zero_bytes(F, ws + WS_L1O, L1O_BYTES);
        const TrJob J[12] = {
            {args.in[I_WRKV], D, D, D, D, (bf16_t*)(ws + W0_CAT)},
            {args.in[I_WRKV] + (size_t)D * D, D, D, D, D, (bf16_t*)(ws + W0_CAT) + (size_t)4096 * D},
            {args.in[I_WRKV] + (size_t)2 * D * D, D, D, D, D, (bf16_t*)(ws + W0_CAT) + (size_t)8192 * D},
            {args.in[I_W1], D, 128, D, 256, (bf16_t*)(ws + W0_CAT) + (size_t)12288 * D},
            {args.in[I_A1], D, 128, D, 256, (bf16_t*)(ws + W0_CAT) + (size_t)12544 * D},
            {args.in[I_G1], D, 480, D, 512, (bf16_t*)(ws + W0_CAT) + (size_t)12800 * D},
            {args.in[I_W2], 128, D, 512, D, (bf16_t*)(ws + W0_L2)},
            {args.in[I_A2], 128, D, 512, D, (bf16_t*)(ws + W0_L2) + (size_t)4096 * 512},
            {args.in[I_G2], 480, D, 512, D, (bf16_t*)(ws + W0_L2) + (size_t)8192 * 512},
            {args.in[I_RWO], D, D, D, D, (bf16_t*)(ws + W0_O)},
            {args.in[I_WUP], D, FF, D, FF, (bf16_t*)(ws + W0_UP)},
            {args.in[I_WDN], FF, D, FF, D, (bf16_t*)(ws + W0_DN)}};
        tr_jobs<12>(F, J);
        mix_phase(F, x, meta, args.in[I_MU], (bf16_t*)(ws + WS_X));
    }
    SEAM(0);
    if (IN(1)) {
        ProbP1 P; P.K = D; P.S.init(33, 52, F.G, bid); P.mixed = (const char*)(ws + WS_X); P.wcat = (const char*)(ws + W0_CAT);
        EpiP1 E{(float*)(ws + WS_Y), (bf16_t*)(ws + WS_L1O)};
        pg8::gemm_phase<ProbP1, EpiP1, true, true>(ring, P, E);
    }
    SEAM(1);
    if (IN(2)) {
        ProbL2 P; P.K = 512; P.S.init(33, 48, F.G, bid); P.l1o = (const char*)(ws + WS_L1O); P.w2 = (const char*)(ws + W0_L2);
        EpiL2 E{(float*)(ws + WS_WDEC), (float*)(ws + WS_AA), (bf16_t*)(ws + WS_GG), args.in[I_W0], args.in[I_A0]};
        pg8::gemm_phase<ProbL2, EpiL2, true, true>(ring, P, E);
    }
    SEAM(2);
    if (IN(3)) {
        ScanArgs A{(const float*)(ws + WS_Y), (const float*)(ws + WS_Y) + (size_t)RP * D, (const float*)(ws + WS_Y) + (size_t)2 * RP * D, (const float*)(ws + WS_WDEC), (const float*)(ws + WS_AA),
                   (const bf16_t*)(ws + WS_GG), (bf16_t*)(ws + WS_YG), args.in[I_KK], args.in[I_KA], args.in[I_RK], args.in[I_GNG], args.in[I_GNB]};
        scan_phase(F, A);
    }
    SEAM(3);
    if (IN(4)) {
        ProbG P; P.K = D; P.S.init(33, 16, F.G, bid); P.A = (const char*)(ws + WS_YG); P.Bt = (const char*)(ws + W0_O);
        EpiRes<true> E{(float*)(ws + WS_ZB), x, meta};
        pg8::gemm_phase<ProbG, EpiRes<true>, true, true>(ring, P, E);
    }
    SEAM(4);
    if (IN(5)) ln_phase(F, (const float*)(ws + WS_ZB), args.in[I_LNMG], args.in[I_LNMB], (float*)(ws + WS_HF), (bf16_t*)(ws + WS_HB), MROWS);
    SEAM(5);
    if (IN(6)) {
        ProbG P; P.K = D; P.S.init(33, 64, F.G, bid); P.A = (const char*)(ws + WS_HB); P.Bt = (const char*)(ws + W0_UP);
        EpiUp E{(bf16_t*)(ws + WS_X)};
        pg8::gemm_phase<ProbG, EpiUp, true, true>(ring, P, E);
    }
    SEAM(6);
    if (IN(7)) {
        ProbG P; P.K = FF; P.S.init(33, 16, F.G, bid); P.A = (const char*)(ws + WS_X); P.Bt = (const char*)(ws + W0_DN);
        EpiRes<false> E{(float*)(ws + WS_ZB), (const float*)(ws + WS_HF), nullptr};
        pg8::gemm_phase<ProbG, EpiRes<false>, true, true>(ring, P, E);
    }
    SEAM(7);
    if (IN(8)) {
        ln_phase(F, (const float*)(ws + WS_ZB), args.in[I_LNFG], args.in[I_LNFB], (float*)(ws + WS_HF), (bf16_t*)(ws + WS_HB), MROWS);
        const TrJob J[4] = {
            {args.in[I_SBQKV], D, 3 * D, D, 3 * D, (bf16_t*)(ws + W1_QKV)},
            {args.in[I_SBO], D, D, D, D, (bf16_t*)(ws + W1_O)},
            {args.in[I_WUP] + (size_t)D * FF, D, FF, D, FF, (bf16_t*)(ws + W1_UP)},
            {args.in[I_WDN] + (size_t)D * FF, FF, D, FF, D, (bf16_t*)(ws + W1_DN)}};
        tr_jobs<4>(F, J);
    }
    SEAM(8);
    if (IN(9)) {
        ProbG P; P.K = D; P.S.init(33, 48, F.G, bid); P.A = (const char*)(ws + WS_HB); P.Bt = (const char*)(ws + W1_QKV);
        EpiQkv E{(bf16_t*)(ws + WS_QB)};
        pg8::gemm_phase<ProbG, EpiQkv, true, true>(ring, P, E);
    }
    SEAM(9);
    if (IN(10)) attn_phase(F, (const bf16_t*)(ws + WS_QB), (const bf16_t*)(ws + WS_KB), (const bf16_t*)(ws + WS_VB), (bf16_t*)(ws + WS_OB));
    SEAM(10);
    if (IN(11)) {
        ProbG P; P.K = D; P.S.init(32, 16, F.G, bid); P.A = (const char*)(ws + WS_OB); P.Bt = (const char*)(ws + W1_O);
        EpiRes<false> E{(float*)(ws + WS_ZB), (const float*)(ws + WS_HF), nullptr};
        pg8::gemm_phase<ProbG, EpiRes<false>, true, true>(ring, P, E);
    }
    SEAM(11);
    if (IN(12)) ln_phase(F, (const float*)(ws + WS_ZB), args.in[I_LNMG] + D, args.in[I_LNMB] + D, (float*)(ws + WS_HF), (bf16_t*)(ws + WS_HB), MREAL);
    SEAM(12);
    if (IN(13)) {
        ProbG P; P.K = D; P.S.init(32, 64, F.G, bid); P.A = (const char*)(ws + WS_HB); P.Bt = (const char*)(ws + W1_UP);
        EpiUp E{(bf16_t*)(ws + WS_X)};
        pg8::gemm_phase<ProbG, EpiUp, true, true>(ring, P, E);
    }
    SEAM(13);
    if (IN(14)) {
        ProbG P; P.K = FF; P.S.init(32, 16, F.G, bid); P.A = (const char*)(ws + WS_X); P.Bt = (const char*)(ws + W1_DN);
        EpiRes<false> E{(float*)(ws + WS_ZB), (const float*)(ws + WS_HF), nullptr};
        pg8::gemm_phase<ProbG, EpiRes<false>, true, true>(ring, P, E);
    }
    SEAM(14);
    if (IN(15)) ln_phase(F, (const float*)(ws + WS_ZB), args.in[I_LNFG] + D, args.in[I_LNFB] + D, args.out, nullptr, MREAL);
#undef IN
#undef SEAM
}

extern "C" void kernel_launch(void* const* d_in, const int* in_sizes, int n_in, void* d_out, int out_size, void* d_ws, size_t ws_size, hipStream_t stream) {
    static int grid = 0;
    if (grid == 0) {
        if (n_in != 26 || in_sizes[0] != MREAL * D || out_size != MREAL * D || ws_size < WS_END) {
            fprintf(stderr, "kernel_launch: unexpected shapes (n_in %d, in0 %d, out %d, ws %zu, need %zu); nothing launched\n", n_in, n_in > 0 ? in_sizes[0] : -1, out_size, ws_size, (size_t)WS_END); grid = -1; return; }
        int dev = 0, cus = 0, per_cu = 0;
        if (hipGetDevice(&dev) != hipSuccess || hipDeviceGetAttribute(&cus, hipDeviceAttributeMultiprocessorCount, dev) != hipSuccess) { grid = -1; return; }
        if (hipFuncSetAttribute((const void*)fwd_kernel, hipFuncAttributeMaxDynamicSharedMemorySize, LDS_BYTES) != hipSuccess) { fprintf(stderr, "kernel_launch: hipFuncSetAttribute failed\n"); grid = -1; return; }
        if (hipOccupancyMaxActiveBlocksPerMultiprocessor(&per_cu, (const void*)fwd_kernel, NWAVES * 64, LDS_BYTES) != hipSuccess || per_cu < 1)
            fprintf(stderr, "kernel_launch: note: occupancy query reports %d workgroups per CU\n", per_cu);
        (void)hipGetLastError();
        grid = cus;
    }
    if (grid < 0) return;
    if (hipMemsetAsync((char*)d_ws + WS_CTL, 0, CTL_ZERO_BYTES, stream) != hipSuccess) return;
    KArgs a{};
    for (int i = 0; i < 26; ++i) a.in[i] = (const float*)d_in[i];
    a.out = (float*)d_out; a.ws = (unsigned char*)d_ws; a.pad = 0;
#if MK_ONE_LAUNCH
    a.ph_lo = 0; a.ph_hi = N_PHASES; a.li = 0;
    hipLaunchKernelGGL(fwd_kernel, dim3(grid), dim3(NWAVES * 64), LDS_BYTES, stream, a);
#else
    for (int p = 0; p < N_PHASES; ++p) { a.ph_lo = p; a.ph_hi = p + 1; a.li = p;
        hipLaunchKernelGGL(fwd_kernel, dim3(grid), dim3(NWAVES * 64), LDS_BYTES, stream, a); }
#endif
}
```

```cpp
#include <hip/hip_runtime.h>
#include <cstdio>
#include <cstdint>

#define LAS __attribute__((address_space(3)))
#define GAS __attribute__((address_space(1)))
typedef unsigned short bf16_t;
typedef short bf16x8 __attribute__((ext_vector_type(8)));
typedef float f32x2 __attribute__((ext_vector_type(2)));
typedef float f32x4 __attribute__((ext_vector_type(4)));
typedef float f32x16 __attribute__((ext_vector_type(16)));
typedef unsigned u32x2 __attribute__((ext_vector_type(2)));
typedef unsigned u32x4 __attribute__((ext_vector_type(4)));
typedef __bf16 bf16v2 __attribute__((ext_vector_type(2)));

__device__ __forceinline__ unsigned pk2(float lo, float hi) { f32x2 v = {lo, hi}; return __builtin_bit_cast(unsigned, __builtin_convertvector(v, bf16v2)); }
__device__ __forceinline__ float bf_lo(unsigned u) { return __builtin_bit_cast(float, u << 16); }
__device__ __forceinline__ float bf_hi(unsigned u) { return __builtin_bit_cast(float, u & 0xffff0000u); }
__device__ __forceinline__ float fexp2(float x) { return __builtin_amdgcn_exp2f(x); }
__device__ __forceinline__ float flog2(float x) { return __builtin_amdgcn_logf(x); }
__device__ __forceinline__ float fexp(float x) { return __builtin_amdgcn_exp2f(x * 1.44269504089f); }
__device__ __forceinline__ float frcp(float x) { return __builtin_amdgcn_rcpf(x); }
__device__ __forceinline__ float fsigmoid(float x) { return frcp(1.0f + fexp(-x)); }
__device__ __forceinline__ float afma(float a, float b, float c) { float d; asm("v_fma_f32 %0, %1, %2, %3" : "=v"(d) : "v"(a), "v"(b), "v"(c)); return d; }
__device__ __forceinline__ float amul(float a, float b) { float d; asm("v_mul_f32 %0, %1, %2" : "=v"(d) : "v"(a), "v"(b)); return d; }
__device__ __forceinline__ float aadd(float a, float b) { float d; asm("v_add_f32 %0, %1, %2" : "=v"(d) : "v"(a), "v"(b)); return d; }
__device__ __forceinline__ f32x2 pfma2(f32x2 a, f32x2 b, f32x2 c) { return __builtin_elementwise_fma(a, b, c); }
__device__ __forceinline__ float asub(float a, float b) { float d; asm("v_sub_f32 %0, %1, %2" : "=v"(d) : "v"(a), "v"(b)); return d; }

constexpr int D = 4096, NBATCH = 4, TSEQ = 2048, NMETA = 16, FF = 16384;
constexpr int MREAL = NBATCH * TSEQ;
constexpr int MROWS = MREAL + NMETA;
constexpr int RP = 8448;
constexpr int RW_H = 64, RW_N = 64;
constexpr int SB_H = 32, SB_D = 128;
constexpr float LN_EPS = 1e-5f, GN_EPS = 64e-5f;
constexpr float DN_ALPHA = 1.4142135623730951f;
constexpr float QSCALE = 0.08838834764831845f * 1.4426950408889634f;

namespace pg8 {
constexpr int BM = 256, BK = 64, HALF = 128, HTB = HALF * BK * 2, STAGE_BYTES = 8 * HTB, NXCD = 8, WGM = 8;
__host__ __device__ __forceinline__ int lds_byte(int r, int c) { const int st = (r >> 4) * 2 + (c >> 5), rr = r & 15, cc = c & 31, ob = rr * 64 + cc * 2; return st * 1024 + (ob ^ (((ob >> 9) & 1) << 5)); }
__host__ __device__ __forceinline__ void stage_rc(int b, int& R, int& C) { const int st = b / 1024, sb = b % 1024, swz = sb ^ (((sb >> 9) & 1) << 5); R = (st >> 1) * 16 + swz / 64; C = (st & 1) * 32 + (swz % 64) / 2; }
__host__ __device__ __forceinline__ int perm32(int rho) { const int n = rho >> 4, i = rho & 15; return 8 * (i >> 2) + 4 * n + (i & 3); }

struct Unit { int pm, pn; };
struct TileOrder {
    int nM, nN, nwg, G, c, nN2, nwg2;
    __device__ __forceinline__ void init(int nM_, int nN_, int G_, int c_, int nN2_ = 0) { nM = nM_; nN = nN_; nwg = nM * nN; G = G_; c = c_; nN2 = nN2_; nwg2 = nM * nN2_; }
    __device__ __forceinline__ bool next(int i, Unit& u) const {
        const long L = (long)i * G + c; if (L >= nwg + nwg2) return false;
        if (L >= nwg) { const int l2 = (int)L - nwg; u.pm = l2 % nM; u.pn = nN + l2 / nM; return true; }
        int wgid = (int)L; { const int q = nwg / NXCD, r = nwg % NXCD, xcd = wgid % NXCD, off = wgid / NXCD; wgid = (xcd < r ? xcd * (q + 1) : r * (q + 1) + (xcd - r) * q) + off; }
        const int nig = WGM * nN, gid = wgid / nig, fm = gid * WGM, gsz = (nM - fm) < WGM ? (nM - fm) : WGM;
        u.pm = fm + ((wgid % nig) % gsz); u.pn = (wgid % nig) / gsz; return true;
    }
};

template <class Prob, class Epi, bool ALIGN_EPI, bool SP2>
__device__ __forceinline__ void gemm_phase(LAS unsigned char* lds, const Prob& P, const Epi& E) {
    const int tid = threadIdx.x, wid = __builtin_amdgcn_readfirstlane(tid >> 6), lane = tid & 63, wr = wid >> 2, wc = wid & 3, fr = lane & 15, fq = lane >> 4;
    const int K = P.K;
    unsigned voffA[2], voffB[2];
#pragma unroll
    for (int i = 0; i < 2; ++i) { int R, C; stage_rc(tid * 16 + i * 8192, R, C); const int Rb = Epi::PERM ? ((R & ~31) + perm32(R & 31)) : R;
        voffA[i] = (unsigned)(R * K + C) * 2u; voffB[i] = (unsigned)(Rb * K + C) * 2u; }
    const size_t kstep = (size_t)(BK * 2);
    const size_t hstep = (size_t)HALF * K * 2;
    const unsigned ldsw = (unsigned)wid * 1024u;
    const int aoff = lds_byte(wr * 64 + fr, fq * 8), boff = lds_byte(wc * 32 + fr, fq * 8);
#define PG8_SA(b, h) (((b) * 2 + (h)) * HTB)
#define PG8_SB(b, h) ((4 + (b) * 2 + (h)) * HTB)
#define PG8_STAGE(bufoff, gbase, voff) do { _Pragma("unroll") for (int _i = 0; _i < 2; ++_i) \
        __builtin_amdgcn_global_load_lds((const unsigned*)((const char*)(gbase) + (voff)[_i]), (LAS unsigned*)(lds + (bufoff) + ldsw + _i * 8192), 16, 0, 0); } while (0)
#define PG8_LDA(dst, b, h) do { _Pragma("unroll") for (int m = 0; m < 4; ++m) _Pragma("unroll") for (int k = 0; k < 2; ++k) dst[m][k] = *(const LAS bf16x8*)(lds + PG8_SA(b, h) + aoff + m * 2048 + k * 1024); } while (0)
#define PG8_LDB(dst, b, h) do { _Pragma("unroll") for (int n = 0; n < 2; ++n) _Pragma("unroll") for (int k = 0; k < 2; ++k) dst[n][k] = *(const LAS bf16x8*)(lds + PG8_SB(b, h) + boff + n * 2048 + k * 1024); } while (0)
#define PG8_MMA(ai, bj, At, Bt) do { __builtin_amdgcn_s_setprio(1); _Pragma("unroll") for (int m = 0; m < 4; ++m) _Pragma("unroll") for (int n = 0; n < 2; ++n) _Pragma("unroll") for (int k = 0; k < 2; ++k) \
        acc[ai][bj][m][n] = __builtin_amdgcn_mfma_f32_16x16x32_bf16(Bt[n][k], At[m][k], acc[ai][bj][m][n], 0, 0, 0); __builtin_amdgcn_s_setprio(0); } while (0)
#define PG8_WAIT_V(n) asm volatile("s_waitcnt vmcnt(" #n ")" ::: "memory")
#define PG8_WAIT_L(n) asm volatile("s_waitcnt lgkmcnt(" #n ")" ::: "memory")
#define PG8_BAR __builtin_amdgcn_s_barrier()
#define PG8_SCHED __builtin_amdgcn_sched_barrier(0)
    Unit cur, nxt; int ui = 0;
    if (!P.S.next(0, cur)) return;
    f32x4 acc[2][2][4][2];
#pragma unroll
    for (int a = 0; a < 2; ++a)
#pragma unroll
        for (int b = 0; b < 2; ++b)
#pragma unroll
            for (int m = 0; m < 4; ++m)
#pragma unroll
                for (int n = 0; n < 2; ++n) acc[a][b][m][n] = (f32x4){0.f, 0.f, 0.f, 0.f};
    bf16x8 At[4][2], B0[2][2], B1[2][2];
    const char* cA = P.a_base(cur); const char* cB = P.b_base(cur);
    if constexpr (SP2) {
        PG8_STAGE(PG8_SB(0, 0), cB, voffB); PG8_STAGE(PG8_SB(0, 1), cB + hstep, voffB); PG8_STAGE(PG8_SA(0, 0), cA, voffA); PG8_STAGE(PG8_SA(0, 1), cA + hstep, voffA);
        if (wr == 1) PG8_BAR;
        PG8_WAIT_V(2); PG8_BAR;
        PG8_STAGE(PG8_SB(1, 0), cB + kstep, voffB); PG8_STAGE(PG8_SA(1, 0), cA + kstep, voffA); PG8_STAGE(PG8_SB(1, 1), cB + hstep + kstep, voffB);
        PG8_WAIT_V(6); PG8_BAR;
    } else {
        PG8_STAGE(PG8_SB(0, 0), cB, voffB); PG8_STAGE(PG8_SA(0, 0), cA, voffA); PG8_STAGE(PG8_SB(0, 1), cB + hstep, voffB); PG8_STAGE(PG8_SA(0, 1), cA + hstep, voffA);
        if (wr == 1) PG8_BAR;
        PG8_WAIT_V(4); PG8_BAR;
        PG8_STAGE(PG8_SB(1, 0), cB + kstep, voffB); PG8_STAGE(PG8_SA(1, 0), cA + kstep, voffA); PG8_STAGE(PG8_SB(1, 1), cB + hstep + kstep, voffB);
        PG8_WAIT_V(6); PG8_BAR;
    }
    for (;;) {
        const bool has_next = P.S.next(ui + 1, nxt);
        const char* nA = has_next ? P.a_base(nxt) : cA; const char* nB = has_next ? P.b_base(nxt) : cB;
        const int nt = P.nkt(cur);
        for (int t = 0; t < nt; t += 2) {
            const bool last = (t == nt - 2);
            const char* a1 = cA + (size_t)(t + 1) * kstep;
            const char* a2 = last ? nA : cA + (size_t)(t + 2) * kstep; const char* b2 = last ? nB : cB + (size_t)(t + 2) * kstep;
            const char* a3 = a2 + kstep; const char* b3 = b2 + kstep;
            if constexpr (SP2) {
            PG8_LDB(B0, 0, 0); PG8_LDB(B1, 0, 1); PG8_SCHED; PG8_LDA(At, 0, 0); PG8_STAGE(PG8_SA(1, 1), a1 + hstep, voffA);
            PG8_WAIT_V(8); PG8_WAIT_L(0); PG8_BAR; PG8_MMA(0, 0, At, B0); PG8_MMA(0, 1, At, B1); PG8_BAR; PG8_SCHED;
            PG8_LDA(At, 0, 1); PG8_STAGE(PG8_SB(0, 0), b2, voffB); PG8_STAGE(PG8_SB(0, 1), b2 + hstep, voffB); PG8_STAGE(PG8_SA(0, 0), a2, voffA);
            PG8_WAIT_V(8); PG8_WAIT_L(0); PG8_BAR; PG8_MMA(1, 0, At, B0); PG8_MMA(1, 1, At, B1); PG8_BAR; PG8_SCHED;
            PG8_LDB(B0, 1, 0); PG8_LDB(B1, 1, 1); PG8_SCHED; PG8_LDA(At, 1, 0); PG8_STAGE(PG8_SA(0, 1), a2 + hstep, voffA);
            PG8_WAIT_V(8); PG8_WAIT_L(0); PG8_BAR; PG8_MMA(0, 0, At, B0); PG8_MMA(0, 1, At, B1); PG8_BAR; PG8_SCHED;
            PG8_LDA(At, 1, 1); PG8_STAGE(PG8_SB(1, 0), b3, voffB); PG8_STAGE(PG8_SB(1, 1), b3 + hstep, voffB); PG8_STAGE(PG8_SA(1, 0), a3, voffA);
            PG8_WAIT_V(8); PG8_WAIT_L(0); PG8_BAR; PG8_MMA(1, 0, At, B0); PG8_MMA(1, 1, At, B1); PG8_BAR; PG8_SCHED;
            } else {
            PG8_LDB(B0, 0, 0); PG8_SCHED; PG8_LDA(At, 0, 0); PG8_STAGE(PG8_SA(1, 1), a1 + hstep, voffA);
            PG8_WAIT_L(8); PG8_BAR; PG8_WAIT_L(0); PG8_MMA(0, 0, At, B0); PG8_BAR; PG8_SCHED;
            PG8_LDB(B1, 0, 1); PG8_STAGE(PG8_SB(0, 0), b2, voffB);
            PG8_BAR; PG8_WAIT_L(0); PG8_MMA(0, 1, At, B1); PG8_BAR;
            PG8_LDA(At, 0, 1); PG8_STAGE(PG8_SA(0, 0), a2, voffA);
            PG8_BAR; PG8_WAIT_L(0); PG8_MMA(1, 0, At, B0); PG8_BAR; PG8_SCHED;
            PG8_STAGE(PG8_SB(0, 1), b2 + hstep, voffB);
            PG8_WAIT_V(6); PG8_BAR; PG8_MMA(1, 1, At, B1); PG8_BAR;
            PG8_LDB(B0, 1, 0); PG8_SCHED; PG8_LDA(At, 1, 0); PG8_STAGE(PG8_SA(0, 1), a2 + hstep, voffA);
            PG8_WAIT_L(8); PG8_BAR; PG8_WAIT_L(0); PG8_MMA(0, 0, At, B0); PG8_BAR; PG8_SCHED;
            PG8_LDB(B1, 1, 1); PG8_STAGE(PG8_SB(1, 0), b3, voffB);
            PG8_BAR; PG8_WAIT_L(0); PG8_MMA(0, 1, At, B1); PG8_BAR;
            PG8_LDA(At, 1, 1); PG8_STAGE(PG8_SA(1, 0), a3, voffA);
            PG8_BAR; PG8_WAIT_L(0); PG8_MMA(1, 0, At, B0); PG8_BAR; PG8_SCHED;
            PG8_STAGE(PG8_SB(1, 1), b3 + hstep, voffB);
            PG8_WAIT_V(6); PG8_BAR; PG8_MMA(1, 1, At, B1); PG8_BAR;
            }
        }
        if constexpr (ALIGN_EPI) { if (wr == 0) PG8_BAR; }
        E(acc, cur, wr, wc, fr, fq);
        if (!has_next) break;
#pragma unroll
        for (int a = 0; a < 2; ++a)
#pragma unroll
            for (int b = 0; b < 2; ++b)
#pragma unroll
                for (int m = 0; m < 4; ++m)
#pragma unroll
                    for (int n = 0; n < 2; ++n) acc[a][b][m][n] = (f32x4){0.f, 0.f, 0.f, 0.f};
        cur = nxt; cA = nA; cB = nB; ++ui;
        if constexpr (ALIGN_EPI) { if (wr == 1) PG8_BAR; }
    }
    PG8_WAIT_V(0);
    if constexpr (!ALIGN_EPI) { if (wr == 0) PG8_BAR; }
    PG8_BAR;
#undef PG8_SA
#undef PG8_SB
#undef PG8_STAGE
#undef PG8_LDA
#undef PG8_LDB
#undef PG8_MMA
#undef PG8_WAIT_V
#undef PG8_WAIT_L
#undef PG8_BAR
#undef PG8_SCHED
}
}
using pg8::Unit;

constexpr size_t MiB = (size_t)1 << 20;
constexpr size_t WS_CTL = 0, CTL_ZERO_BYTES = 1 * MiB;
constexpr size_t WS_W = 1 * MiB;
constexpr size_t W0_CAT = WS_W;
constexpr size_t W0_L2 = W0_CAT + 104 * MiB;
constexpr size_t W0_O = W0_L2 + 12 * MiB;
constexpr size_t W0_UP = W0_O + 32 * MiB;
constexpr size_t W0_DN = W0_UP + 128 * MiB;
constexpr size_t WS_X = WS_W + 404 * MiB;
constexpr size_t W1_QKV = WS_X;
constexpr size_t W1_O = W1_QKV + 96 * MiB;
constexpr size_t W1_UP = W1_O + 32 * MiB;
constexpr size_t W1_DN = W1_UP + 128 * MiB;
constexpr size_t ACT_BF = (size_t)RP * D * 2;
constexpr size_t ACT_F32 = (size_t)RP * D * 4;
constexpr size_t WS_Y = WS_X + 396 * MiB;
constexpr size_t WS_ZB = WS_Y, WS_HF = WS_Y + 132 * MiB, WS_HB = WS_Y + 264 * MiB;
constexpr size_t WS_Z = WS_Y + 396 * MiB;
constexpr size_t WS_L1O = WS_Z;
constexpr size_t L1O_BYTES = (size_t)3 * RP * 512 * 2;
constexpr size_t WS_WDEC = WS_Z + 25 * MiB, WS_AA = WS_WDEC + 132 * MiB, WS_GG = WS_AA + 132 * MiB, WS_YG = WS_GG + 66 * MiB;
constexpr size_t WS_QB = WS_Z, WS_KB = WS_Z + 66 * MiB, WS_VB = WS_Z + 132 * MiB, WS_OB = WS_Z + 198 * MiB;
constexpr size_t WS_U0 = WS_Z;
constexpr size_t WS_U1 = WS_W;
constexpr size_t WS_END = WS_Z + 421 * MiB;
static_assert(W1_DN + 128 * MiB <= WS_X + 396 * MiB && (size_t)RP * FF * 2 <= 404 * MiB && (size_t)RP * FF * 2 <= 421 * MiB && L1O_BYTES <= 25 * MiB && WS_YG + ACT_BF <= WS_END && W0_DN + 128 * MiB <= WS_X && 6 * ACT_BF <= 396 * MiB && 3 * ACT_F32 <= 396 * MiB, "ws map");
constexpr int CW_TMO = 0;
constexpr int CW_BAR = 4096;
constexpr size_t CTL_STATS = 512 * 1024;
constexpr size_t STATS_BYTES = (size_t)RP * 2 * 4;
static_assert(CTL_STATS + 4 * STATS_BYTES <= CTL_ZERO_BYTES, "stats inside the per-call memset");

constexpr int NWAVES = 8;
constexpr int RING_BYTES = 131072;
constexpr int LDSCTL_OFF = 139264, MISC_OFF = LDSCTL_OFF + 320;
constexpr int LDS_BYTES = 147456;

#define XB_TMO      128
#define XB_XCNT(j)  (256  + 64 * (j))
#define XB_XSUB(j)  (1280 + 64 * (j))
#define XB_XGEN(j)  (2304 + 64 * (j))
#define XB_TOP      3328
#define XB_TOPGEN   3392
#define XCD_BAR_WORDS 3456
#define XB_SPIN_CAP (1u << 18)
__device__ __forceinline__ unsigned xb_ld(unsigned* p)              { return __hip_atomic_load(p, __ATOMIC_RELAXED, __HIP_MEMORY_SCOPE_AGENT); }
__device__ __forceinline__ unsigned xb_add(unsigned* p, unsigned v) { return __hip_atomic_fetch_add(p, v, __ATOMIC_RELAXED, __HIP_MEMORY_SCOPE_AGENT); }
__device__ __forceinline__ unsigned xb_xcc_id() { return (unsigned)__builtin_amdgcn_s_getreg((3 << 11) | 20) & 0xFu; }
#define XB_SPIN(cond, bar) do { unsigned _sp = 0; while (cond) { __builtin_amdgcn_s_sleep(1); \
    if ((++_sp & 255u) == 0u) { if (xb_ld(&(bar)[XB_TMO])) break; if (_sp > XB_SPIN_CAP) { atomicAdd(&(bar)[XB_TMO], 1u); break; } } } } while (0)
struct XcdBarrier { unsigned* bar; unsigned x; volatile LAS unsigned* st; };
__device__ __forceinline__ XcdBarrier xcd_barrier_post(unsigned* bar, volatile LAS unsigned* st) {
    XcdBarrier b; b.bar = bar; b.x = xb_xcc_id(); b.st = st;
    if (threadIdx.x == 0) (void)xb_add(&bar[XB_XCNT(b.x)], 1u);
    return b;
}
__device__ __forceinline__ void xcd_barrier_complete(unsigned* bar, unsigned x, unsigned& nloc, unsigned& nx) {
    const unsigned G = gridDim.x * gridDim.y * gridDim.z;
    unsigned sum, cnt, mine, sp = 0u;
    for (;;) {
        sum = 0u; cnt = 0u; mine = 0u;
#pragma unroll
        for (unsigned j = 0; j < 16; ++j) { const unsigned c = xb_ld(&bar[XB_XCNT(j)]); sum += c; cnt += (c > 0u) ? 1u : 0u; mine = (j == x) ? c : mine; }
        if (sum == G) break;
        __builtin_amdgcn_s_sleep(1);
        if ((++sp & 255u) == 0u) { if (xb_ld(&bar[XB_TMO])) break; if (sp > XB_SPIN_CAP) { atomicAdd(&bar[XB_TMO], 1u); break; } }
    }
    nloc = mine > 0u ? mine : 1u; nx = cnt > 0u ? cnt : 1u;
}
__device__ __forceinline__ void xcd_barrier(const XcdBarrier& b) {
    asm volatile("s_waitcnt vmcnt(0)" ::: "memory");
    __syncthreads();
    if (threadIdx.x == 0) {
        unsigned* bar = b.bar;
        __builtin_amdgcn_s_waitcnt(0);
        unsigned nloc = b.st[0], nx = b.st[1];
        if (nloc == 0u) { xcd_barrier_complete(bar, b.x, nloc, nx); b.st[0] = nloc; b.st[1] = nx; }
        const unsigned old = xb_add(&bar[XB_XSUB(b.x)], 1u);
        const unsigned gen = old / nloc;
        if (old + 1u == (gen + 1u) * nloc) {
            __builtin_amdgcn_fence(__ATOMIC_RELEASE, "agent");
            asm volatile("s_waitcnt vmcnt(0)" ::: "memory");
            const unsigned og = xb_add(&bar[XB_TOP], 1u);
            const unsigned tg = og / nx;
            if (og + 1u == (tg + 1u) * nx) xb_add(&bar[XB_TOPGEN], 1u);
            else XB_SPIN(xb_ld(&bar[XB_TOPGEN]) == tg, bar);
            __builtin_amdgcn_fence(__ATOMIC_ACQUIRE, "agent");
            xb_add(&bar[XB_XGEN(b.x)], 1u);
            asm volatile("s_waitcnt vmcnt(0)" ::: "memory");
        } else {
            XB_SPIN(xb_ld(&bar[XB_XGEN(b.x)]) == gen, bar);
            __builtin_amdgcn_fence(__ATOMIC_ACQUIRE, "agent");
            asm volatile("s_waitcnt vmcnt(0)" ::: "memory");
        }
    }
    __syncthreads();
}

struct Params { const float* in[26]; float* out; unsigned char* ws; int ph_lo, ph_hi; };
enum { I_X = 0, I_META, I_LNMG, I_LNMB, I_LNFG, I_LNFB, I_WUP, I_WDN, I_MU, I_WRKV, I_W0, I_W1, I_W2, I_A0, I_A1, I_A2, I_G1, I_G2, I_KK, I_KA, I_RK, I_GNG, I_GNB, I_RWO, I_SBQKV, I_SBO };

struct Frame {
    LAS unsigned char* lds;
    int tid, lane, wave, vcu, G;
};
__device__ __forceinline__ float red16(float x) {
    x += __builtin_bit_cast(float, __builtin_amdgcn_update_dpp(0, __builtin_bit_cast(int, x), 0xB1, 0xF, 0xF, true));
    x += __builtin_bit_cast(float, __builtin_amdgcn_update_dpp(0, __builtin_bit_cast(int, x), 0x4E, 0xF, 0xF, true));
    x += __builtin_bit_cast(float, __builtin_amdgcn_update_dpp(0, __builtin_bit_cast(int, x), 0x141, 0xF, 0xF, true));
    x += __builtin_bit_cast(float, __builtin_amdgcn_update_dpp(0, __builtin_bit_cast(int, x), 0x140, 0xF, 0xF, true));
    return x;
}
template <int CTRL> __device__ __forceinline__ float dpp_mov(float v) { return __builtin_bit_cast(float, __builtin_amdgcn_update_dpp(0, __builtin_bit_cast(int, v), CTRL, 0xF, 0xF, true)); }
template <int CTRL> __device__ __forceinline__ f32x4 dpp_stage4(f32x4 x) { f32x4 t; t[0] = dpp_mov<CTRL>(x[0]); t[1] = dpp_mov<CTRL>(x[1]); t[2] = dpp_mov<CTRL>(x[2]); t[3] = dpp_mov<CTRL>(x[3]); return x + t; }
__device__ __forceinline__ f32x4 red16x4(f32x4 x) {
    float a = x[0], b = x[1], c = x[2], d = x[3];
#define R16_ROW(mod) "v_add_f32_dpp %0, %0, %0 " mod " row_mask:0xf bank_mask:0xf bound_ctrl:1\n\tv_add_f32_dpp %1, %1, %1 " mod " row_mask:0xf bank_mask:0xf bound_ctrl:1\n\t" \
                     "v_add_f32_dpp %2, %2, %2 " mod " row_mask:0xf bank_mask:0xf bound_ctrl:1\n\tv_add_f32_dpp %3, %3, %3 " mod " row_mask:0xf bank_mask:0xf bound_ctrl:1\n\t"
    asm volatile("s_nop 1\n\t" R16_ROW("quad_perm:[1,0,3,2]") R16_ROW("quad_perm:[2,3,0,1]") R16_ROW("row_half_mirror") R16_ROW("row_mirror") : "+v"(a), "+v"(b), "+v"(c), "+v"(d));
#undef R16_ROW
    return (f32x4){a, b, c, d};
}
__device__ __forceinline__ float wave_sum(float v) {
#pragma unroll
    for (int o = 1; o < 64; o <<= 1) v += __shfl_xor(v, o);
    return v;
}

__device__ __forceinline__ size_t hm_off(int row, int col) { return ((size_t)((row >> 11) * 64 + (col >> 6)) << 17) + (size_t)((row & 2047) * 64 + (col & 63)); }
__device__ __forceinline__ size_t hm_off_meta(int m, int col) { return (size_t)MREAL * D + (size_t)(((col >> 6) * 16 + m) * 64 + (col & 63)); }
struct ProbP1 {
    int K; pg8::TileOrder S; const char* mixed; const char* wcat;
    __device__ __forceinline__ const char* a_base(const Unit& u) const { const int gi = u.pn < 44 ? (u.pn >> 4) : (u.pn >= 48 ? 2 : (u.pn == 44 ? 3 : (u.pn == 45 ? 4 : 5)));
        return mixed + (size_t)gi * ACT_BF + (size_t)u.pm * 256 * D * 2 + (u.pn >= 48 ? (size_t)((u.pn - 48) & 1) * 4096 : (size_t)0); }
    __device__ __forceinline__ const char* b_base(const Unit& u) const { const int wt = u.pn < 44 ? u.pn : (u.pn < 48 ? u.pn + 4 : 44 + ((u.pn - 48) >> 1));
        return wcat + (size_t)wt * 256 * D * 2 + (u.pn >= 48 ? (size_t)((u.pn - 48) & 1) * 4096 : (size_t)0); }
    __device__ __forceinline__ int nkt(const Unit& u) const { return u.pn < 48 ? 64 : 32; }
};
struct EpiP1 {
    static constexpr bool PERM = false;
    bf16_t* rkv; bf16_t* l1o;
    __device__ __forceinline__ void operator()(const f32x4 (&acc)[2][2][4][2], const Unit& u, int wr, int wc, int fr, int fq) const {
        const int row0 = u.pm * 256 + wr * 64 + fr, c0 = wc * 32 + 4 * fq;
        if (u.pn < 44 || u.pn >= 48) {
            const int sub = u.pn < 44 ? (u.pn >> 4) : 2 + ((u.pn - 48) & 1), ct = u.pn < 44 ? (u.pn & 15) : 12 + ((u.pn - 48) >> 1);
            bf16_t* C = rkv + (size_t)sub * RP * D + hm_off(row0, ct * 256 + c0);
#pragma unroll
            for (int ai = 0; ai < 2; ++ai)
#pragma unroll
                for (int m = 0; m < 4; ++m) {
#pragma unroll
                    for (int bj = 0; bj < 2; ++bj)
#pragma unroll
                        for (int n = 0; n < 2; ++n) { const f32x4 v = acc[ai][bj][m][n]; u32x2 w; w.x = pk2(v[0], v[1]); w.y = pk2(v[2], v[3]); *(u32x2*)(C + (size_t)((ai * 128 + m * 16) * 64 + bj * (2 << 17) + n * 16)) = w; } }
        } else {
            const int lt = u.pn - 44, sub = lt < 2 ? lt : 2;
            bf16_t* O = l1o + (size_t)sub * RP * 512 + (lt == 3 ? 256 : 0) + c0;
#pragma unroll
            for (int ai = 0; ai < 2; ++ai)
#pragma unroll
                for (int m = 0; m < 4; ++m) { bf16_t* rowp = O + (size_t)(row0 + ai * 128 + m * 16) * 512;
#pragma unroll
                    for (int bj = 0; bj < 2; ++bj)
#pragma unroll
                        for (int n = 0; n < 2; ++n) { f32x4 v = acc[ai][bj][m][n];
                            if (sub == 0) {
#pragma unroll
                                for (int j = 0; j < 4; ++j) v[j] = 1.0f - 2.0f * frcp(fexp(2.0f * v[j]) + 1.0f);
                            } else if (sub == 2) {
#pragma unroll
                                for (int j = 0; j < 4; ++j) v[j] = fsigmoid(v[j]);
                            }
                            u32x2 w; w.x = pk2(v[0], v[1]); w.y = pk2(v[2], v[3]); *(u32x2*)(rowp + bj * 128 + n * 16) = w; } }
        }
    }
};
struct ProbL2 {
    int K; pg8::TileOrder S; const char* l1o; const char* w2;
    __device__ __forceinline__ const char* a_base(const Unit& u) const { return l1o + (size_t)(u.pn >> 4) * RP * 512 * 2 + (size_t)u.pm * 256 * 512 * 2; }
    __device__ __forceinline__ const char* b_base(const Unit& u) const { return w2 + (size_t)u.pn * 256 * 512 * 2; }
    __device__ __forceinline__ int nkt(const Unit& u) const { return (u.pn >> 4) < 2 ? 4 : 8; }
};
struct EpiL2 {
    static constexpr bool PERM = false;
    bf16_t* wdec; bf16_t* aa; bf16_t* gg; const float* w0; const float* a0;
    __device__ __forceinline__ void operator()(const f32x4 (&acc)[2][2][4][2], const Unit& u, int wr, int wc, int fr, int fq) const {
        const int row0 = u.pm * 256 + wr * 64 + fr, col0 = (u.pn & 15) * 256 + wc * 32 + 4 * fq, sub = u.pn >> 4;
        const size_t hbase = hm_off(row0, col0);
#pragma unroll
        for (int bj = 0; bj < 2; ++bj)
#pragma unroll
            for (int n = 0; n < 2; ++n) { const int col = col0 + bj * 128 + n * 16;
                f32x4 bias = (f32x4){0.f, 0.f, 0.f, 0.f};
                if (sub == 0) bias = *(const f32x4*)(w0 + col); else if (sub == 1) bias = *(const f32x4*)(a0 + col);
#pragma unroll
                for (int ai = 0; ai < 2; ++ai)
#pragma unroll
                    for (int m = 0; m < 4; ++m) { const size_t off = hbase + (size_t)((ai * 128 + m * 16) * 64 + bj * (2 << 17) + n * 16);
                        f32x4 v = acc[ai][bj][m][n] + bias;
                        if (sub == 0) {
#pragma unroll
                            for (int j = 0; j < 4; ++j) v[j] = 1.0f - fexp(-0.60653065971f * fsigmoid(v[j]));
                            { u32x2 w; w.x = pk2(v[0], v[1]); w.y = pk2(v[2], v[3]); *(u32x2*)(wdec + off) = w; }
                        } else if (sub == 1) {
#pragma unroll
                            for (int j = 0; j < 4; ++j) v[j] = fsigmoid(v[j]);
                            { u32x2 w; w.x = pk2(v[0], v[1]); w.y = pk2(v[2], v[3]); *(u32x2*)(aa + off) = w; }
                        } else { u32x2 w; w.x = pk2(v[0], v[1]); w.y = pk2(v[2], v[3]); *(u32x2*)(gg + off) = w; } } }
    }
};
struct ProbG {
    int K; pg8::TileOrder S; const char* A; const char* Bt;
    __device__ __forceinline__ const char* a_base(const Unit& u) const { return A + (size_t)u.pm * 256 * K * 2; }
    __device__ __forceinline__ const char* b_base(const Unit& u) const { return Bt + (size_t)u.pn * 256 * K * 2; }
    __device__ __forceinline__ int nkt(const Unit&) const { return K / 64; }
};
struct ProbQkv {
    int K; pg8::TileOrder S; const char* hb; const char* w;
    __device__ __forceinline__ const char* a_base(const Unit& u) const { return u.pn < 32 ? hb + (size_t)u.pm * 256 * D * 2 : w + (size_t)(8192 + (u.pn - 32) * 256) * D * 2; }
    __device__ __forceinline__ const char* b_base(const Unit& u) const { return u.pn < 32 ? w + (size_t)u.pn * 256 * D * 2 : hb + (size_t)u.pm * 256 * D * 2; }
    __device__ __forceinline__ int nkt(const Unit&) const { return D / 64; }
};
__device__ __forceinline__ void ln_row_stats(const float* st, int row, float& rho, float& nmr) {
    const float s1 = st[2 * row], s2 = st[2 * row + 1];
    const float mean = s1 * (1.0f / D), var = fmaxf(s2 * (1.0f / D) - mean * mean, 0.f);
    rho = __builtin_amdgcn_rsqf(var + LN_EPS); nmr = -mean * rho;
}
template <bool LNRES> struct EpiRes {
    static constexpr bool PERM = false;
    float* z; const float* res; const float* st_in; const float* g; const float* b; float* st_out;
    __device__ __forceinline__ void operator()(const f32x4 (&acc)[2][2][4][2], const Unit& u, int wr, int wc, int fr, int fq) const {
        const int row0 = u.pm * 256 + wr * 64 + fr, col0 = u.pn * 256 + wc * 32 + 4 * fq;
        f32x4 gv[2][2], bv[2][2];
        if (LNRES) {
#pragma unroll
            for (int bj = 0; bj < 2; ++bj)
#pragma unroll
                for (int n = 0; n < 2; ++n) { gv[bj][n] = *(const f32x4*)(g + col0 + bj * 128 + n * 16); bv[bj][n] = *(const f32x4*)(b + col0 + bj * 128 + n * 16); }
        }
#pragma unroll
        for (int ai = 0; ai < 2; ++ai)
#pragma unroll
            for (int m = 0; m < 4; ++m) { const int row = row0 + ai * 128 + m * 16;
                const float* rp = res + (size_t)row * D + col0;
                float* zp = z + (size_t)row * D + col0;
                float rho = 1.f, nmr = 0.f;
                if (LNRES) ln_row_stats(st_in, row, rho, nmr);
                float s1 = 0.f, s2 = 0.f;
#pragma unroll
                for (int bj = 0; bj < 2; ++bj)
#pragma unroll
                    for (int n = 0; n < 2; ++n) { f32x4 r = *(const f32x4*)(rp + bj * 128 + n * 16);
                        if (LNRES) r = (r * rho + nmr) * gv[bj][n] + bv[bj][n];
                        const f32x4 zz = r * DN_ALPHA + acc[ai][bj][m][n];
                        *(f32x4*)(zp + bj * 128 + n * 16) = zz;
                        s1 += (zz[0] + zz[1]) + (zz[2] + zz[3]); s2 += (zz[0] * zz[0] + zz[1] * zz[1]) + (zz[2] * zz[2] + zz[3] * zz[3]); }
                s1 += __shfl_xor(s1, 16); s2 += __shfl_xor(s2, 16); s1 += __shfl_xor(s1, 32); s2 += __shfl_xor(s2, 32);
                if (fq == 0) { atomicAdd(st_out + 2 * row, s1); atomicAdd(st_out + 2 * row + 1, s2); } }
    }
};
struct EpiUp {
    static constexpr bool PERM = true;
    bf16_t* O;
    __device__ __forceinline__ void operator()(const f32x4 (&acc)[2][2][4][2], const Unit& u, int wr, int wc, int fr, int fq) const {
        const int row0 = u.pm * 256 + wr * 64 + fr, col0 = u.pn * 256 + wc * 32 + 8 * fq;
#pragma unroll
        for (int ai = 0; ai < 2; ++ai)
#pragma unroll
            for (int m = 0; m < 4; ++m) { bf16_t* rowp = O + (size_t)(row0 + ai * 128 + m * 16) * FF + col0;
#pragma unroll
                for (int bj = 0; bj < 2; ++bj) { f32x4 v0 = acc[ai][bj][m][0], v1 = acc[ai][bj][m][1];
#pragma unroll
                    for (int j = 0; j < 4; ++j) { const float a = fmaxf(v0[j], 0.f), b = fmaxf(v1[j], 0.f); v0[j] = a * a; v1[j] = b * b; }
                    u32x4 w; w.x = pk2(v0[0], v0[1]); w.y = pk2(v0[2], v0[3]); w.z = pk2(v1[0], v1[1]); w.w = pk2(v1[2], v1[3]);
                    *(u32x4*)(rowp + bj * 128) = w; } }
    }
};
struct EpiQkv {
    static constexpr bool PERM = true;
    bf16_t* qb;
    __device__ __forceinline__ void operator()(const f32x4 (&acc)[2][2][4][2], const Unit& u, int wr, int wc, int fr, int fq) const {
        const int t = u.pn >> 4; const float sc = (t == 0) ? QSCALE : 1.0f;
        bf16_t* O; size_t ld;
        if (t < 2) { O = qb + (size_t)t * RP * D + (size_t)(u.pm * 256) * D + (u.pn & 15) * 256; ld = D; }
        else { O = qb + (size_t)2 * RP * D + (size_t)((u.pn - 32) * 256) * RP + u.pm * 256; ld = RP; }
        O += (size_t)(wr * 64 + fr) * ld + wc * 32 + 8 * fq;
#pragma unroll
        for (int ai = 0; ai < 2; ++ai)
#pragma unroll
            for (int m = 0; m < 4; ++m) { bf16_t* rowp = O + (size_t)(ai * 128 + m * 16) * ld;
#pragma unroll
                for (int bj = 0; bj < 2; ++bj) { const f32x4 v0 = acc[ai][bj][m][0] * sc, v1 = acc[ai][bj][m][1] * sc;
                    u32x4 w; w.x = pk2(v0[0], v0[1]); w.y = pk2(v0[2], v0[3]); w.z = pk2(v1[0], v1[1]); w.w = pk2(v1[2], v1[3]);
                    *(u32x4*)(rowp + bj * 128) = w; } }
    }
};

__device__ __forceinline__ void tr_item(const float* W, int K, int N, int nblk, bf16_t* WT, int Kp, LAS float* scr, int item, int lane) {
    const int kb = item / nblk, nb = item - kb * nblk, k0 = 64 * kb, n0 = 32 * nb;
    const int lr = lane >> 3, lc = (lane & 7) * 4;
    f32x4 v[8];
#pragma unroll
    for (int i = 0; i < 8; ++i) { const int k = k0 + lr + 8 * i, n = n0 + lc; v[i] = (k < K && n < N) ? *(const f32x4*)(W + (size_t)k * N + n) : (f32x4){0.f, 0.f, 0.f, 0.f}; }
#pragma unroll
    for (int i = 0; i < 8; ++i) { LAS float* s = scr + (lr + 8 * i) * 33 + lc; s[0] = v[i].x; s[1] = v[i].y; s[2] = v[i].z; s[3] = v[i].w; }
    asm volatile("s_waitcnt lgkmcnt(0)" ::: "memory");
    const int c = lane & 7;
#pragma unroll
    for (int j = 0; j < 4; ++j) { const int n = (lane >> 3) + 8 * j; const LAS float* s = scr + (8 * c) * 33 + n;
        u32x4 o; o.x = pk2(s[0], s[33]); o.y = pk2(s[66], s[99]); o.z = pk2(s[132], s[165]); o.w = pk2(s[198], s[231]);
        *(u32x4*)(WT + (size_t)(n0 + n) * Kp + k0 + 8 * c) = o; }
    asm volatile("s_waitcnt lgkmcnt(0)" ::: "memory");
}
struct TrJob { const float* W; int K, N, Kp, Np; bf16_t* WT; };
template <int NJ> __device__ __forceinline__ int tr_total(const TrJob (&J)[NJ]) { int t = 0;
#pragma unroll
    for (int j = 0; j < NJ; ++j) t += (J[j].Kp / 64) * (J[j].Np / 32);
    return t; }
template <int NJ> __device__ __forceinline__ void tr_jobs(const Frame& F, const TrJob (&J)[NJ]) {
    LAS float* scr = (LAS float*)(F.lds + F.wave * 8448);
    const int gw = F.vcu * NWAVES + F.wave, NGW = F.G * NWAVES;
    const int total = tr_total<NJ>(J);
    for (int it = gw; it < total; it += NGW) {
        int r = it;
#pragma unroll
        for (int j = 0; j < NJ; ++j) { const int n = (J[j].Kp / 64) * (J[j].Np / 32);
            if (r >= 0 && r < n) tr_item(J[j].W, J[j].K, J[j].N, J[j].Np / 32, J[j].WT, J[j].Kp, scr, r, F.lane);
            r -= n; }
    }
}
struct TrRef { const float* W; bf16_t* WT; int N, Kp; };
template <int NJ> __device__ __forceinline__ TrRef tr_lookup(const TrJob (&J)[NJ], int it) {
    TrRef R; R.W = J[0].W; R.WT = J[0].WT; R.N = 32; R.Kp = 64;
    int r = it;
#pragma unroll
    for (int j = 0; j < NJ; ++j) { const int nblk = J[j].Np / 32, n = (J[j].Kp / 64) * nblk;
        if (r >= 0 && r < n) { const int kb = r / nblk, nb = r - kb * nblk; R.N = J[j].N; R.Kp = J[j].Kp;
            R.W = J[j].W + (size_t)(64 * kb) * J[j].N + 32 * nb; R.WT = J[j].WT + (size_t)(32 * nb) * J[j].Kp + 64 * kb; }
        r -= n; }
    return R;
}
__device__ __forceinline__ void tr_load(const TrRef& R, int lane, f32x4 (&v)[8]) {
    const unsigned off = (unsigned)((2 * (lane >> 3)) * R.N + 4 * (lane & 7));
#pragma unroll
    for (int i = 0; i < 4; ++i) { const float* p = R.W + (size_t)(16 * i) * R.N; v[2 * i] = __builtin_nontemporal_load((const f32x4*)(p + off)); v[2 * i + 1] = __builtin_nontemporal_load((const f32x4*)(p + R.N + off)); }
}
__device__ __forceinline__ void tr_store(const TrRef& R, int lane, const f32x4 (&v)[8], LAS unsigned* scr) {
    const int lr = lane >> 3, lc = 4 * (lane & 7);
#pragma unroll
    for (int i = 0; i < 4; ++i)
#pragma unroll
        for (int q = 0; q < 4; ++q) scr[(lc + q) * 36 + 8 * i + lr] = pk2(v[2 * i][q], v[2 * i + 1][q]);
    asm volatile("s_waitcnt lgkmcnt(0)" ::: "memory");
    const unsigned off = (unsigned)((lane >> 3) * R.Kp + 8 * (lane & 7));
#pragma unroll
    for (int j = 0; j < 4; ++j) { const u32x4 o = *(const LAS u32x4*)(scr + ((lane >> 3) + 8 * j) * 36 + 4 * (lane & 7)); *(u32x4*)(R.WT + (size_t)(8 * j) * R.Kp + off) = o; }
    asm volatile("s_waitcnt lgkmcnt(0)" ::: "memory");
}
__device__ __forceinline__ void mix_phase(const Frame& F, const float* x, const float* meta, const float* mu, bf16_t* mixed) {
    const int gw = F.vcu * NWAVES + F.wave, NGW = F.G * NWAVES;
    for (int task = gw; task < 16 * 257; task += NGW) {
        const int cc = task & 15, rr = task >> 4, col = cc * 256 + F.lane * 4;
        const int row0 = rr < 256 ? rr * 32 : MREAL, nrows = rr < 256 ? 32 : NMETA;
        f32x4 m4[6];
#pragma unroll
        for (int n = 0; n < 6; ++n) m4[n] = *(const f32x4*)(mu + (size_t)n * D + col);
        f32x4 prev = (f32x4){0.f, 0.f, 0.f, 0.f};
        if (rr < 256) prev = ((row0 & (TSEQ - 1)) == 0) ? *(const f32x4*)(meta + (size_t)(NMETA - 1) * D + col) : *(const f32x4*)(x + (size_t)(row0 - 1) * D + col);
        const float* src = rr < 256 ? x + (size_t)row0 * D + col : meta + col;
#pragma unroll 4
        for (int i = 0; i < nrows; ++i) {
            const f32x4 h = *(const f32x4*)(src + (size_t)i * D);
            const f32x4 xx = prev - h;
#pragma unroll
            for (int n = 0; n < 6; ++n) { const f32x4 m = h + xx * m4[n]; u32x2 w; w.x = pk2(m[0], m[1]); w.y = pk2(m[2], m[3]);
                *(u32x2*)(mixed + (size_t)n * RP * D + (size_t)(row0 + i) * D + col) = w; }
            prev = h;
        }
    }
}
__device__ __forceinline__ void zero_bytes(const Frame& F, unsigned char* p, size_t nbytes) {
    const size_t n16 = nbytes / 16, stride = (size_t)F.G * NWAVES * 64;
    for (size_t i = (size_t)(F.vcu * NWAVES + F.wave) * 64 + F.lane; i < n16; i += stride) ((u32x4*)p)[i] = (u32x4){0u, 0u, 0u, 0u};
}
__device__ __forceinline__ void ln_apply(const Frame& F, const float* z, const float* st, const float* g, const float* b, bf16_t* hb, float* out, int nrows) {
    const int gw = F.vcu * NWAVES + F.wave, NGW = F.G * NWAVES;
    for (int row = gw; row < nrows; row += NGW) {
        float rho, nmr; ln_row_stats(st, row, rho, nmr);
        const f32x4* zr = (const f32x4*)(z + (size_t)row * D) + F.lane;
        f32x4 v[16];
#pragma unroll
        for (int j = 0; j < 16; ++j) v[j] = zr[64 * j];
#pragma unroll
        for (int j = 0; j < 16; ++j) { const int col = (64 * j + F.lane) * 4;
            const f32x4 o = (v[j] * rho + nmr) * *(const f32x4*)(g + col) + *(const f32x4*)(b + col);
            if (out) *(f32x4*)(out + (size_t)row * D + col) = o;
            if (hb) { u32x2 w; w.x = pk2(o[0], o[1]); w.y = pk2(o[2], o[3]); *(u32x2*)(hb + (size_t)row * D + col) = w; } }
    }
}
template <int STEPS, class SP> __device__ __forceinline__ void skinny_gemm(const Frame& F, int K, int ntiles, const SP& P) {
    LAS float* PS = (LAS float*)F.lds;
    const int lane = F.lane, r = lane & 15, kq = lane >> 4, kw = K >> 3;
    for (int t = F.vcu; t < ntiles; t += F.G) {
        const bf16_t* A; const bf16_t* B; int lda;
        P.tile(t, A, lda, B);
        const bf16_t* ap = A + (size_t)r * lda + F.wave * kw + kq * 8;
        const bf16_t* bp = B + (size_t)r * K + F.wave * kw + kq * 8;
        f32x4 acc = (f32x4){0.f, 0.f, 0.f, 0.f};
        for (int i0 = 0; i0 < kw; i0 += 32 * STEPS) {
            bf16x8 a[STEPS], b[STEPS];
#pragma unroll
            for (int i = 0; i < STEPS; ++i) { a[i] = *(const bf16x8*)(ap + i0 + 32 * i); b[i] = *(const bf16x8*)(bp + i0 + 32 * i); }
#pragma unroll
            for (int i = 0; i < STEPS; ++i) acc = __builtin_amdgcn_mfma_f32_16x16x32_bf16(a[i], b[i], acc, 0, 0, 0);
        }
#pragma unroll
        for (int j = 0; j < 4; ++j) PS[F.wave * 256 + (kq * 4 + j) * 16 + r] = acc[j];
        __syncthreads();
        if (F.tid < 256) { float v = 0.f;
#pragma unroll
            for (int w = 0; w < 8; ++w) v += PS[w * 256 + F.tid];
            P.out(t, F.tid >> 4, F.tid & 15, v); }
        __syncthreads();
    }
}
struct SkP1 {
    const bf16_t* mixed; const bf16_t* wcat; bf16_t* rkv; bf16_t* l1o;
    __device__ __forceinline__ int n0(int t) const { return t < 768 ? 16 * t : (t < 776 ? 12288 + 16 * (t - 768) : (t < 784 ? 12544 + 16 * (t - 776) : 12800 + 16 * (t - 784))); }
    __device__ __forceinline__ void tile(int t, const bf16_t*& A, int& lda, const bf16_t*& B) const {
        const int gi = t < 768 ? t >> 8 : (t < 776 ? 3 : (t < 784 ? 4 : 5));
        A = mixed + (size_t)gi * RP * D + (size_t)MREAL * D; lda = D; B = wcat + (size_t)n0(t) * D; }
    __device__ __forceinline__ void out(int t, int row, int c, float v) const {
        if (t < 768) rkv[(size_t)(t >> 8) * RP * D + hm_off_meta(row, 16 * (t & 255) + c)] = (bf16_t)(pk2(v, 0.f) & 0xffffu);
        else if (t < 776) l1o[(size_t)(MREAL + row) * 512 + 16 * (t - 768) + c] = (bf16_t)(pk2(1.0f - 2.0f * frcp(fexp(2.0f * v) + 1.0f), 0.f) & 0xffffu);
        else if (t < 784) l1o[(size_t)RP * 512 + (size_t)(MREAL + row) * 512 + 16 * (t - 776) + c] = (bf16_t)(pk2(v, 0.f) & 0xffffu);
        else l1o[(size_t)2 * RP * 512 + (size_t)(MREAL + row) * 512 + 16 * (t - 784) + c] = (bf16_t)(pk2(fsigmoid(v), 0.f) & 0xffffu);
    }
};
struct SkL2 {
    const bf16_t* l1o; const bf16_t* w2; bf16_t* wdec; bf16_t* aa; bf16_t* gg; const float* w0; const float* a0;
    __device__ __forceinline__ void tile(int t, const bf16_t*& A, int& lda, const bf16_t*& B) const { A = l1o + (size_t)(t >> 8) * RP * 512 + (size_t)MREAL * 512; lda = 512; B = w2 + (size_t)16 * t * 512; }
    __device__ __forceinline__ void out(int t, int row, int c, float v) const {
        const int sub = t >> 8, col = 16 * (t & 255) + c; const size_t off = hm_off_meta(row, col);
        if (sub == 0) wdec[off] = (bf16_t)(pk2(1.0f - fexp(-0.60653065971f * fsigmoid(v + w0[col])), 0.f) & 0xffffu);
        else if (sub == 1) aa[off] = (bf16_t)(pk2(fsigmoid(v + a0[col]), 0.f) & 0xffffu);
        else gg[off] = (bf16_t)(pk2(v, 0.f) & 0xffffu);
    }
};
template <bool LNRES> struct SkRes {
    const bf16_t* A_; int lda_; const bf16_t* Bt; int K; float* z; const float* res; const float* st_in; const float* g; const float* b; float* st_out;
    __device__ __forceinline__ void tile(int t, const bf16_t*& A, int& lda, const bf16_t*& B) const { A = A_; lda = lda_; B = Bt + (size_t)16 * t * K; }
    __device__ __forceinline__ void out(int t, int row, int c, float v) const { const int col = 16 * t + c; const size_t off = (size_t)row * D + col;
        float r = res[off];
        if (LNRES) { float rho, nmr; ln_row_stats(st_in, MREAL + row, rho, nmr); r = (r * rho + nmr) * g[col] + b[col]; }
        const float zz = DN_ALPHA * r + v; z[off] = zz;
        const float s1 = red16(zz), s2 = red16(zz * zz);
        if (c == 0) { atomicAdd(st_out + 2 * (MREAL + row), s1); atomicAdd(st_out + 2 * (MREAL + row) + 1, s2); } }
};
struct SkUp {
    const bf16_t* hb; const bf16_t* Bt; bf16_t* u;
    __device__ __forceinline__ void tile(int t, const bf16_t*& A, int& lda, const bf16_t*& B) const { A = hb; lda = D; B = Bt + (size_t)16 * t * D; }
    __device__ __forceinline__ void out(int t, int row, int c, float v) const { const float a = fmaxf(v, 0.f); u[(size_t)row * FF + 16 * t + c] = (bf16_t)(pk2(a * a, 0.f) & 0xffffu); }
};
struct SkKv {
    const bf16_t* hb; const bf16_t* Bt; bf16_t* kb;
    __device__ __forceinline__ void tile(int t, const bf16_t*& A, int& lda, const bf16_t*& B) const { A = hb; lda = D; B = Bt + (size_t)16 * t * D; }
    __device__ __forceinline__ void out(int t, int row, int c, float v) const {
        if (t < 256) kb[(size_t)row * D + 16 * t + c] = (bf16_t)(pk2(v, 0.f) & 0xffffu);
        else (kb - (size_t)MREAL * D + (size_t)RP * D)[(size_t)(16 * (t - 256) + c) * RP + MREAL + row] = (bf16_t)(pk2(v, 0.f) & 0xffffu); }
};

constexpr int SC_RDY = 0;
constexpr int SC_VB = SC_RDY + 32 * 5 * 64 * 4;
constexpr int SC_YR = SC_VB + 32 * 64 * 4;
struct ScanArgs { const bf16_t* r; const bf16_t* k; const bf16_t* v; const bf16_t* v2; const bf16_t* w; const bf16_t* a; const bf16_t* g; bf16_t* yg;
                  const float* k_k; const float* k_a; const float* r_k; const float* gn_g; const float* gn_b; };
constexpr int SC_SIDE = 65536;
__device__ __forceinline__ f32x4 red8x4(f32x4 x) {
    float a = x[0], b = x[1], c = x[2], d = x[3];
#define R8_ROW(mod) "v_add_f32_dpp %0, %0, %0 " mod " row_mask:0xf bank_mask:0xf bound_ctrl:1\n\tv_add_f32_dpp %1, %1, %1 " mod " row_mask:0xf bank_mask:0xf bound_ctrl:1\n\t" \
                    "v_add_f32_dpp %2, %2, %2 " mod " row_mask:0xf bank_mask:0xf bound_ctrl:1\n\tv_add_f32_dpp %3, %3, %3 " mod " row_mask:0xf bank_mask:0xf bound_ctrl:1\n\t"
    asm volatile("s_nop 1\n\t" R8_ROW("quad_perm:[1,0,3,2]") R8_ROW("quad_perm:[2,3,0,1]") R8_ROW("row_half_mirror") : "+v"(a), "+v"(b), "+v"(c), "+v"(d));
#undef R8_ROW
    return (f32x4){a, b, c, d};
}
template <int NJ> __device__ __forceinline__ void scan_phase(const Frame& F, const ScanArgs& A, const TrJob (&J)[NJ]) {
    LAS float* RDY = (LAS float*)(F.lds + SC_RDY); LAS float* VB = (LAS float*)(F.lds + SC_VB); LAS float* YR = (LAS float*)(F.lds + SC_YR);
    const int tid = F.tid, lane = F.lane, w = F.wave;
    const int tt = tid >> 4, j4 = (tid & 15) * 4;
    const int c8 = (lane & 7) * 8, i0 = 16 * (w & 3) + 2 * (lane >> 3);
    LAS unsigned* sscr = (LAS unsigned*)(F.lds + SC_SIDE + (w & 3) * 4608);
    const int side_total = tr_total<NJ>(J), gsw = F.vcu * 4 + (w & 3), NSW = F.G * 4;
    int side_next = gsw;
    for (int bh = blockIdx.x; bh < NBATCH * RW_H; bh += F.G) {
        const int b = bh >> 6, h = bh & 63, col = h * 64 + j4;
        const f32x4 ckk = *(const f32x4*)(A.k_k + col), cka = *(const f32x4*)(A.k_a + col), crk = *(const f32x4*)(A.r_k + col);
        const f32x4 cgg = *(const f32x4*)(A.gn_g + col), cgb = *(const f32x4*)(A.gn_b + col);
        f32x2 S0[4], S1[4];
#pragma unroll
        for (int q = 0; q < 4; ++q) { S0[q] = (f32x2){0.f, 0.f}; S1[q] = (f32x2){0.f, 0.f}; }
        u32x2 qr, qk, qv, qw, qa, qv2 = (u32x2){0u, 0u};
        {
            const size_t off = hm_off_meta(tt & 15, col);
            qr = *(const u32x2*)(A.r + off); qk = *(const u32x2*)(A.k + off); qv = *(const u32x2*)(A.v + off); qw = *(const u32x2*)(A.w + off); qa = *(const u32x2*)(A.a + off);
        }
        for (int c = 0; c <= 64; ++c) {
            const int nsteps = c == 0 ? NMETA : 32;
            const int rowbase = c == 0 ? MREAL : b * TSEQ + (c - 1) * 32;
            const bool act = tt < nsteps;
            const f32x4 pr = {bf_lo(qr.x), bf_hi(qr.x), bf_lo(qr.y), bf_hi(qr.y)}, pk = {bf_lo(qk.x), bf_hi(qk.x), bf_lo(qk.y), bf_hi(qk.y)}, pv = {bf_lo(qv.x) + bf_lo(qv2.x), bf_hi(qv.x) + bf_hi(qv2.x), bf_lo(qv.y) + bf_lo(qv2.y), bf_hi(qv.y) + bf_hi(qv2.y)};
            const f32x4 pw = {1.0f - bf_lo(qw.x), 1.0f - bf_hi(qw.x), 1.0f - bf_lo(qw.y), 1.0f - bf_hi(qw.y)}, pa = {bf_lo(qa.x), bf_hi(qa.x), bf_lo(qa.y), bf_hi(qa.y)};
            const f32x4 kx = pk * ckk;
            const float ss = red16((kx[0] * kx[0] + kx[1] * kx[1]) + (kx[2] * kx[2] + kx[3] * kx[3]));
            const float inv = 1.0f / fmaxf(sqrtf(ss), 1e-12f);
            const f32x4 kk = kx * inv;
            const f32x4 kp = pk * ((pa - 1.0f) * cka + 1.0f);
            const f32x4 bb = -(kk * pa);
            const f32x4 wr4 = pw * pr;
            const float br = red16((bb[0] * pr[0] + bb[1] * pr[1]) + (bb[2] * pr[2] + bb[3] * pr[3]));
            const float kr = red16((kp[0] * pr[0] + kp[1] * pr[1]) + (kp[2] * pr[2] + kp[3] * pr[3]));
            const f32x4 rkk = pr * kp * crk;
            const float bonus = red16((rkk[0] + rkk[1]) + (rkk[2] + rkk[3]));
            const f32x4 vkeep = pv;
            if (act) {
                LAS float* rd = RDY + tt * 320 + j4;
                *(LAS f32x4*)(rd) = kk; *(LAS f32x4*)(rd + 64) = wr4; *(LAS f32x4*)(rd + 128) = pw; *(LAS f32x4*)(rd + 192) = bb; *(LAS f32x4*)(rd + 256) = kp;
                *(LAS f32x4*)(VB + tt * 64 + j4) = pv;
            }
            u32x2 pg = (u32x2){0u, 0u};
            if (act) pg = *(const u32x2*)(A.g + (c == 0 ? hm_off_meta(tt, col) : hm_off(rowbase + tt, col)));
            if (c < 64) { const size_t off = hm_off(b * TSEQ + c * 32 + tt, col);
                qr = *(const u32x2*)(A.r + off); qk = *(const u32x2*)(A.k + off); qv = *(const u32x2*)(A.v + off); qw = *(const u32x2*)(A.w + off); qa = *(const u32x2*)(A.a + off);
                if (h >= 48) qv2 = *(const u32x2*)(A.v2 + off); }
            __syncthreads();
            if (w < 4) {
                const LAS float* rd = RDY + c8;
                f32x4 kkA = *(const LAS f32x4*)(rd), kkB = *(const LAS f32x4*)(rd + 4), wrA = *(const LAS f32x4*)(rd + 64), wrB = *(const LAS f32x4*)(rd + 68), wA = *(const LAS f32x4*)(rd + 128), wB = *(const LAS f32x4*)(rd + 132);
                f32x4 bA = *(const LAS f32x4*)(rd + 192), bB = *(const LAS f32x4*)(rd + 196), kpA = *(const LAS f32x4*)(rd + 256), kpB = *(const LAS f32x4*)(rd + 260);
                f32x2 v2 = *(const LAS f32x2*)(VB + i0);
#pragma unroll 2
                for (int s = 0; s < nsteps; ++s) {
                    const int sn = (s + 1 < nsteps) ? s + 1 : s;
                    const LAS float* rn = RDY + sn * 320 + c8;
                    const f32x4 nkkA = *(const LAS f32x4*)(rn), nkkB = *(const LAS f32x4*)(rn + 4), nwrA = *(const LAS f32x4*)(rn + 64), nwrB = *(const LAS f32x4*)(rn + 68), nwA = *(const LAS f32x4*)(rn + 128), nwB = *(const LAS f32x4*)(rn + 132);
                    const f32x4 nbA = *(const LAS f32x4*)(rn + 192), nbB = *(const LAS f32x4*)(rn + 196), nkpA = *(const LAS f32x4*)(rn + 256), nkpB = *(const LAS f32x4*)(rn + 260);
                    const f32x2 nv = *(const LAS f32x2*)(VB + sn * 64 + i0);
                    const f32x2 kkv[4] = {{kkA[0], kkA[1]}, {kkA[2], kkA[3]}, {kkB[0], kkB[1]}, {kkB[2], kkB[3]}}, wrv[4] = {{wrA[0], wrA[1]}, {wrA[2], wrA[3]}, {wrB[0], wrB[1]}, {wrB[2], wrB[3]}};
                    const f32x2 wv[4] = {{wA[0], wA[1]}, {wA[2], wA[3]}, {wB[0], wB[1]}, {wB[2], wB[3]}}, bv[4] = {{bA[0], bA[1]}, {bA[2], bA[3]}, {bB[0], bB[1]}, {bB[2], bB[3]}};
                    const f32x2 kpv[4] = {{kpA[0], kpA[1]}, {kpA[2], kpA[3]}, {kpB[0], kpB[1]}, {kpB[2], kpB[3]}};
                    f32x2 d0 = S0[0] * kkv[0], d1 = S1[0] * kkv[0], d2 = S0[0] * wrv[0], d3 = S1[0] * wrv[0];
#pragma unroll
                    for (int q = 1; q < 4; ++q) { d0 = pfma2(S0[q], kkv[q], d0); d1 = pfma2(S1[q], kkv[q], d1); d2 = pfma2(S0[q], wrv[q], d2); d3 = pfma2(S1[q], wrv[q], d3); }
                    f32x4 dd; dd[0] = d0[0] + d0[1]; dd[1] = d1[0] + d1[1]; dd[2] = d2[0] + d2[1]; dd[3] = d3[0] + d3[1];
                    const f32x2 v0 = {v2[0], v2[0]}, v1 = {v2[1], v2[1]};
                    f32x2 T0[4], T1[4];
#pragma unroll
                    for (int q = 0; q < 4; ++q) { T0[q] = pfma2(S0[q], wv[q], v0 * kpv[q]); T1[q] = pfma2(S1[q], wv[q], v1 * kpv[q]); }
                    dd = red8x4(dd);
                    const f32x2 p0 = {dd[0], dd[0]}, p1 = {dd[1], dd[1]};
#pragma unroll
                    for (int q = 0; q < 4; ++q) { S0[q] = pfma2(p0, bv[q], T0[q]); S1[q] = pfma2(p1, bv[q], T1[q]); }
                    if ((lane & 7) == 0) *(LAS f32x4*)(YR + s * 128 + i0 * 2) = dd;
                    kkA = nkkA; kkB = nkkB; wrA = nwrA; wrB = nwrB; wA = nwA; wB = nwB; bA = nbA; bB = nbB; kpA = nkpA; kpB = nkpB; v2 = nv;
                }
            } else {
                const bool h0 = side_next < side_total, h1 = side_next + NSW < side_total, h2 = side_next + 2 * NSW < side_total;
                const TrRef R0 = tr_lookup<NJ>(J, side_next), R1 = tr_lookup<NJ>(J, side_next + NSW), R2 = tr_lookup<NJ>(J, side_next + 2 * NSW);
                f32x4 sv0[8], sv1[8];
                if (h0) tr_load(R0, lane, sv0);
                if (h1) tr_load(R1, lane, sv1);
                if (h0) tr_store(R0, lane, sv0, sscr);
                if (h2) tr_load(R2, lane, sv0);
                if (h1) tr_store(R1, lane, sv1, sscr);
                if (h2) tr_store(R2, lane, sv0, sscr);
                side_next += 3 * NSW;
            }
            __syncthreads();
            if (act && (c > 0 || b == 0)) {
                const f32x4 ya = *(const LAS f32x4*)(YR + tt * 128 + j4 * 2), yb = *(const LAS f32x4*)(YR + tt * 128 + j4 * 2 + 4);
                f32x4 y4;
                y4[0] = ya[2] + ya[0] * br + vkeep[0] * kr; y4[1] = ya[3] + ya[1] * br + vkeep[1] * kr;
                y4[2] = yb[2] + yb[0] * br + vkeep[2] * kr; y4[3] = yb[3] + yb[1] * br + vkeep[3] * kr;
                const float mu = red16((y4[0] + y4[1]) + (y4[2] + y4[3])) * (1.0f / 64.0f);
                const f32x4 d = y4 - mu;
                const float var = red16((d[0] * d[0] + d[1] * d[1]) + (d[2] * d[2] + d[3] * d[3])) * (1.0f / 64.0f);
                const float rstd = 1.0f / sqrtf(var + GN_EPS);
                f32x4 o = d * rstd * cgg + cgb + vkeep * bonus;
                o[0] *= bf_lo(pg.x); o[1] *= bf_hi(pg.x); o[2] *= bf_lo(pg.y); o[3] *= bf_hi(pg.y);
                u32x2 wv; wv.x = pk2(o[0], o[1]); wv.y = pk2(o[2], o[3]);
                *(u32x2*)(A.yg + (size_t)(rowbase + tt) * D + col) = wv;
            }
        }
        __syncthreads();
    }
    if (w >= 4) {
        for (int it = side_next; it < side_total; it += NSW) {
            const TrRef R = tr_lookup<NJ>(J, it); f32x4 v[8]; tr_load(R, lane, v); tr_store(R, lane, v, sscr); }
    }
}

constexpr int AT_KT = 0;
constexpr int AT_VT = 32768;
constexpr int AT_QS = 65536;
#define MFMA32(a, b, c) __builtin_amdgcn_mfma_f32_32x32x16_bf16((a), (b), (c), 0, 0, 0)
typedef _Float16 f16x8 __attribute__((ext_vector_type(8)));
typedef _Float16 f16x2 __attribute__((ext_vector_type(2)));
__device__ __forceinline__ unsigned pkh2(float lo, float hi) { f32x2 v = {lo, hi}; return __builtin_bit_cast(unsigned, __builtin_convertvector(v, f16x2)); }
__device__ __forceinline__ void attn_phase(const Frame& F, const bf16_t* qb, const bf16_t* kb, const bf16_t* vt, bf16_t* ob) {
    const int lane = F.lane, w = F.wave, c = lane & 31, h = lane >> 5;
    LAS unsigned char* KT = F.lds + AT_KT; LAS unsigned char* VT = F.lds + AT_VT;
    f16x8 U[2];
#pragma unroll
    for (int s = 0; s < 2; ++s)
#pragma unroll
        for (int j = 0; j < 8; ++j) { const int kin = 16 * s + 8 * (j >> 2) + 4 * h + (j & 3); U[s][j] = kin >= c ? (_Float16)-1.0f : (_Float16)0.0f; }
    const int dk_key = 4 * w + (lane >> 4), dk_ch = (lane & 15) ^ (dk_key & 15);
    const int dv_d = 16 * w + (lane >> 2), dv_ch = (lane & 3) ^ ((dv_d >> 2) & 3);
    for (int unit = blockIdx.x; unit < NBATCH * SB_H * 4; unit += F.G) {
        const int bh = unit >> 2, pr = unit & 3, b = bh >> 5, hh = bh & 31;
        const bf16_t* kcol = kb + hh * SB_D + dk_ch * 8;
        const bf16_t* vrow = vt + (size_t)(hh * SB_D + dv_d) * RP + dv_ch * 8;
        for (int half = 0; half < 2; ++half) {
            const int Q0 = (half == 0 ? 7 - pr : pr) * 256, q0 = Q0 + 32 * w, diag = q0 >> 5;
            const size_t qrow = (size_t)b * TSEQ + q0 + c;
            LAS unsigned char* QS = F.lds + AT_QS + w * 8192 + c * 256;
#pragma unroll
            for (int ks = 0; ks < 8; ++ks) *(LAS bf16x8*)(QS + (((2 * ks + h) ^ (c & 15)) * 16)) = *(const bf16x8*)(qb + qrow * D + hh * SB_D + 16 * ks + 8 * h);
            f32x16 O[4];
#pragma unroll
            for (int dt = 0; dt < 4; ++dt)
#pragma unroll
                for (int i = 0; i < 16; ++i) O[dt][i] = 0.f;
            float carry = 0.f;
            const int stmax = (Q0 >> 5) + 7, nstg = stmax + 2;
#define AT_DMA(n_) do { const int n__ = (n_); const int slot = n__ & 3; const bool mt = (n__ == nstg - 1); \
                const size_t tok = mt ? (size_t)MREAL : (size_t)b * TSEQ + 32 * (stmax - n__); \
                const bf16_t* ksrc = kcol + (tok + (mt ? (dk_key & 15) : dk_key)) * D; \
                const bf16_t* vsrc = mt ? (vrow - dv_ch * 8 + (dv_ch & 1) * 8 + tok) : (vrow + tok); \
                __builtin_amdgcn_global_load_lds((const unsigned*)ksrc, (LAS unsigned*)(KT + slot * 8192 + w * 1024), 16, 0, 0); \
                __builtin_amdgcn_global_load_lds((const unsigned*)vsrc, (LAS unsigned*)(VT + slot * 8192 + w * 1024), 16, 0, 0); } while (0)
            AT_DMA(0); AT_DMA(1); AT_DMA(2);
            for (int n = 0; n < nstg; ++n) {
                const int rem = nstg - 1 - n;
                if (rem >= 2) asm volatile("s_waitcnt vmcnt(4)" ::: "memory"); else if (rem == 1) asm volatile("s_waitcnt vmcnt(2)" ::: "memory"); else asm volatile("s_waitcnt vmcnt(0)" ::: "memory");
                __builtin_amdgcn_s_barrier();
                asm volatile("" ::: "memory");
                if (n + 3 < nstg) AT_DMA(n + 3);
                const LAS unsigned char* KTb = KT + (n & 3) * 8192; const LAS unsigned char* VTb = VT + (n & 3) * 8192;
                const bool meta = (n == nstg - 1);
                const int st_abs = stmax - n;
                if (meta || st_abs <= diag) {
                    const int limit = meta ? NMETA : ((st_abs == diag) ? c : 64);
                    f32x16 Z;
#pragma unroll
                    for (int i = 0; i < 16; ++i) Z[i] = 0.f;
#pragma unroll
                    for (int ks = 0; ks < 8; ++ks) { const bf16x8 a = *(const LAS bf16x8*)(KTb + c * 256 + (((2 * ks + h) ^ (c & 15)) * 16)); const bf16x8 qf = *(const LAS bf16x8*)(QS + (((2 * ks + h) ^ (c & 15)) * 16)); Z = MFMA32(a, qf, Z); }
                    f32x16 X, Y;
#pragma unroll
                    for (int i = 0; i < 16; ++i) X[i] = flog2(1.0f + fexp2(fminf(Z[i], 100.f)));
                    if (limit < 64) {
#pragma unroll
                        for (int i = 0; i < 16; ++i) { const int row = (i & 3) + 8 * (i >> 2) + 4 * h; X[i] = row < limit ? X[i] : 0.f; }
                    }
#pragma unroll
                    for (int i = 0; i < 16; ++i) Y[i] = Z[i] + carry;
                    f16x8 Xh[2];
#pragma unroll
                    for (int s = 0; s < 2; ++s) { u32x4 hu;
#pragma unroll
                        for (int jj = 0; jj < 4; ++jj) hu[jj] = pkh2(X[8 * s + 2 * jj], X[8 * s + 2 * jj + 1]);
                        Xh[s] = __builtin_bit_cast(f16x8, hu); }
                    Y = __builtin_amdgcn_mfma_f32_32x32x16_f16(U[0], Xh[0], Y, 0, 0, 0); Y = __builtin_amdgcn_mfma_f32_32x32x16_f16(U[1], Xh[1], Y, 0, 0, 0);
                    carry = __shfl(Y[0] - Z[0], c);
#pragma unroll
                    for (int i = 0; i < 16; ++i) Y[i] = fexp2(Y[i]);
                    if (limit < 64) {
#pragma unroll
                        for (int i = 0; i < 16; ++i) { const int row = (i & 3) + 8 * (i >> 2) + 4 * h; Y[i] = row < limit ? Y[i] : 0.f; }
                    }
                    bf16x8 Pb[2];
#pragma unroll
                    for (int s = 0; s < 2; ++s) { u32x4 pu;
#pragma unroll
                        for (int jj = 0; jj < 4; ++jj) pu[jj] = pk2(Y[8 * s + 2 * jj], Y[8 * s + 2 * jj + 1]);
                        Pb[s] = __builtin_bit_cast(bf16x8, pu); }
#pragma unroll
                    for (int dt = 0; dt < 4; ++dt) { const int d = 32 * dt + c; const LAS unsigned char* rowp = VTb + d * 64 + 8 * h; const int sw = (d >> 2) & 3;
#pragma unroll
                        for (int s = 0; s < 2; ++s) {
                            const u32x2 lo = *(const LAS u32x2*)(rowp + (((2 * s) ^ sw) * 16)), hi = *(const LAS u32x2*)(rowp + (((2 * s + 1) ^ sw) * 16));
                            const u32x4 av = (u32x4){lo.x, lo.y, hi.x, hi.y};
                            O[dt] = MFMA32(__builtin_bit_cast(bf16x8, av), Pb[s], O[dt]); } }
                }
            }
#undef AT_DMA
#pragma unroll
            for (int dt = 0; dt < 4; ++dt)
#pragma unroll
                for (int g = 0; g < 4; ++g) { u32x2 wv; wv.x = pk2(O[dt][4 * g], O[dt][4 * g + 1]); wv.y = pk2(O[dt][4 * g + 2], O[dt][4 * g + 3]);
                    *(u32x2*)(ob + qrow * D + hh * SB_D + 32 * dt + 8 * g + 4 * h) = wv; }
            __syncthreads();
        }
    }
}

constexpr int N_PHASES = 16;
#ifndef MK_ONE_LAUNCH
#define MK_ONE_LAUNCH 1
#endif
#ifndef MK_PROBE_SK
#define MK_PROBE_SK 0
#endif
#ifndef MK_PROBE_MASK
#define MK_PROBE_MASK 0u
#endif
struct KArgs { const float* in[26]; float* out; unsigned char* ws; int ph_lo, ph_hi, li, pad; };

template <int PH> __device__ __forceinline__ void run_phase(const Frame& F, const KArgs& args) {
    unsigned char* ws = args.ws;
    const float* x = args.in[I_X]; const float* meta = args.in[I_META];
    LAS unsigned char* ring = F.lds;
    const int bid = (int)blockIdx.x;
    float* const ZA = (float*)(ws + WS_ZB); float* const ZB2 = (float*)(ws + WS_HF);
    float* const ST1 = (float*)(ws + WS_CTL + CTL_STATS), * const ST2 = ST1 + 2 * RP, * const ST3 = ST2 + 2 * RP, * const ST4 = ST3 + 2 * RP;
    const float* const g_m0 = args.in[I_LNMG]; const float* const b_m0 = args.in[I_LNMB]; const float* const g_f0 = args.in[I_LNFG]; const float* const b_f0 = args.in[I_LNFB];
    const float* const g_m1 = g_m0 + D; const float* const b_m1 = b_m0 + D; const float* const g_f1 = g_f0 + D; const float* const b_f1 = b_f0 + D;
    if constexpr (PH == 0) {
        zero_bytes(F, ws + WS_L1O, L1O_BYTES);
        const TrJob J[9] = {
            {args.in[I_WRKV], D, D, D, D, (bf16_t*)(ws + W0_CAT)},
            {args.in[I_WRKV] + (size_t)D * D, D, D, D, D, (bf16_t*)(ws + W0_CAT) + (size_t)4096 * D},
            {args.in[I_WRKV] + (size_t)2 * D * D, D, D, D, D, (bf16_t*)(ws + W0_CAT) + (size_t)8192 * D},
            {args.in[I_W1], D, 128, D, 256, (bf16_t*)(ws + W0_CAT) + (size_t)12288 * D},
            {args.in[I_A1], D, 128, D, 256, (bf16_t*)(ws + W0_CAT) + (size_t)12544 * D},
            {args.in[I_G1], D, 480, D, 512, (bf16_t*)(ws + W0_CAT) + (size_t)12800 * D},
            {args.in[I_W2], 128, D, 512, D, (bf16_t*)(ws + W0_L2)},
            {args.in[I_A2], 128, D, 512, D, (bf16_t*)(ws + W0_L2) + (size_t)4096 * 512},
            {args.in[I_G2], 480, D, 512, D, (bf16_t*)(ws + W0_L2) + (size_t)8192 * 512}};
        tr_jobs<9>(F, J);
        mix_phase(F, x, meta, args.in[I_MU], (bf16_t*)(ws + WS_X));
    } else if constexpr (PH == 1) {
        { SkP1 Q{(const bf16_t*)(ws + WS_X), (const bf16_t*)(ws + W0_CAT), (bf16_t*)(ws + WS_Y), (bf16_t*)(ws + WS_L1O)}; skinny_gemm<16>(F, D, 814, Q); if (MK_PROBE_SK) skinny_gemm<16>(F, D, 814, Q); }
        ProbP1 P; P.K = D; P.S.init(32, 48, F.G, bid, 8); P.mixed = (const char*)(ws + WS_X); P.wcat = (const char*)(ws + W0_CAT);
        EpiP1 E{(bf16_t*)(ws + WS_Y), (bf16_t*)(ws + WS_L1O)};
        pg8::gemm_phase<ProbP1, EpiP1, true, true>(ring, P, E);
    } else if constexpr (PH == 2) {
        { SkL2 Q{(const bf16_t*)(ws + WS_L1O), (const bf16_t*)(ws + W0_L2), (bf16_t*)(ws + WS_WDEC), (bf16_t*)(ws + WS_AA), (bf16_t*)(ws + WS_GG), args.in[I_W0], args.in[I_A0]}; skinny_gemm<2>(F, 512, 768, Q); if (MK_PROBE_SK) skinny_gemm<2>(F, 512, 768, Q); }
        ProbL2 P; P.K = 512; P.S.init(32, 48, F.G, bid); P.l1o = (const char*)(ws + WS_L1O); P.w2 = (const char*)(ws + W0_L2);
        EpiL2 E{(bf16_t*)(ws + WS_WDEC), (bf16_t*)(ws + WS_AA), (bf16_t*)(ws + WS_GG), args.in[I_W0], args.in[I_A0]};
        pg8::gemm_phase<ProbL2, EpiL2, true, true>(ring, P, E);
    } else if constexpr (PH == 3) {
        ScanArgs A{(const bf16_t*)(ws + WS_Y), (const bf16_t*)(ws + WS_Y) + (size_t)RP * D, (const bf16_t*)(ws + WS_Y) + (size_t)2 * RP * D, (const bf16_t*)(ws + WS_Y) + (size_t)3 * RP * D, (const bf16_t*)(ws + WS_WDEC), (const bf16_t*)(ws + WS_AA),
                   (const bf16_t*)(ws + WS_GG), (bf16_t*)(ws + WS_YG), args.in[I_KK], args.in[I_KA], args.in[I_RK], args.in[I_GNG], args.in[I_GNB]};
        const TrJob J[7] = {
            {args.in[I_RWO], D, D, D, D, (bf16_t*)(ws + W0_O)},
            {args.in[I_WUP], D, FF, D, FF, (bf16_t*)(ws + W0_UP)},
            {args.in[I_WDN], FF, D, FF, D, (bf16_t*)(ws + W0_DN)},
            {args.in[I_SBQKV], D, 3 * D, D, 3 * D, (bf16_t*)(ws + W1_QKV)},
            {args.in[I_SBO], D, D, D, D, (bf16_t*)(ws + W1_O)},
            {args.in[I_WUP] + (size_t)D * FF, D, FF, D, FF, (bf16_t*)(ws + W1_UP)},
            {args.in[I_WDN] + (size_t)D * FF, FF, D, FF, D, (bf16_t*)(ws + W1_DN)}};
        scan_phase(F, A, J);
    } else if constexpr (PH == 4) {
        { SkRes<false> Q{(const bf16_t*)(ws + WS_YG) + (size_t)MREAL * D, D, (const bf16_t*)(ws + W0_O), D, ZA + (size_t)MREAL * D, meta, nullptr, nullptr, nullptr, ST1}; skinny_gemm<16>(F, D, 256, Q); }
        ProbG P; P.K = D; P.S.init(32, 16, F.G, bid); P.A = (const char*)(ws + WS_YG); P.Bt = (const char*)(ws + W0_O);
        EpiRes<false> E{ZA, x, nullptr, nullptr, nullptr, ST1};
        pg8::gemm_phase<ProbG, EpiRes<false>, true, true>(ring, P, E);
    } else if constexpr (PH == 5) {
        ln_apply(F, ZA, ST1, g_m0, b_m0, (bf16_t*)(ws + WS_HB), nullptr, MROWS);
    } else if constexpr (PH == 6) {
        { SkUp Q{(const bf16_t*)(ws + WS_HB) + (size_t)MREAL * D, (const bf16_t*)(ws + W0_UP), (bf16_t*)(ws + WS_U0) + (size_t)MREAL * FF}; skinny_gemm<16>(F, D, 1024, Q); if (MK_PROBE_SK) skinny_gemm<16>(F, D, 1024, Q); }
        ProbG P; P.K = D; P.S.init(32, 64, F.G, bid); P.A = (const char*)(ws + WS_HB); P.Bt = (const char*)(ws + W0_UP);
        EpiUp E{(bf16_t*)(ws + WS_U0)};
        pg8::gemm_phase<ProbG, EpiUp, true, true>(ring, P, E);
    } else if constexpr (PH == 7) {
        { SkRes<true> Q{(const bf16_t*)(ws + WS_U0) + (size_t)MREAL * FF, FF, (const bf16_t*)(ws + W0_DN), FF, ZB2 + (size_t)MREAL * D, ZA + (size_t)MREAL * D, ST1, g_m0, b_m0, ST2}; skinny_gemm<16>(F, FF, 256, Q); }
        ProbG P; P.K = FF; P.S.init(32, 16, F.G, bid); P.A = (const char*)(ws + WS_U0); P.Bt = (const char*)(ws + W0_DN);
        EpiRes<true> E{ZB2, ZA, ST1, g_m0, b_m0, ST2};
        pg8::gemm_phase<ProbG, EpiRes<true>, true, true>(ring, P, E);
    } else if constexpr (PH == 8) {
        ln_apply(F, ZB2, ST2, g_f0, b_f0, (bf16_t*)(ws + WS_HB), nullptr, MROWS);
    } else if constexpr (PH == 9) {
        { SkKv Q{(const bf16_t*)(ws + WS_HB) + (size_t)MREAL * D, (const bf16_t*)(ws + W1_QKV) + (size_t)D * D, (bf16_t*)(ws + WS_KB) + (size_t)MREAL * D}; skinny_gemm<16>(F, D, 512, Q); if (MK_PROBE_SK) skinny_gemm<16>(F, D, 512, Q); }
        ProbQkv P; P.K = D; P.S.init(32, 48, F.G, bid); P.hb = (const char*)(ws + WS_HB); P.w = (const char*)(ws + W1_QKV);
        EpiQkv E{(bf16_t*)(ws + WS_QB)};
        pg8::gemm_phase<ProbQkv, EpiQkv, true, true>(ring, P, E);
    } else if constexpr (PH == 10) {
        attn_phase(F, (const bf16_t*)(ws + WS_QB), (const bf16_t*)(ws + WS_KB), (const bf16_t*)(ws + WS_VB), (bf16_t*)(ws + WS_OB));
    } else if constexpr (PH == 11) {
        ProbG P; P.K = D; P.S.init(32, 16, F.G, bid); P.A = (const char*)(ws + WS_OB); P.Bt = (const char*)(ws + W1_O);
        EpiRes<true> E{ZA, ZB2, ST2, g_f0, b_f0, ST3};
        pg8::gemm_phase<ProbG, EpiRes<true>, true, true>(ring, P, E);
    } else if constexpr (PH == 12) {
        ln_apply(F, ZA, ST3, g_m1, b_m1, (bf16_t*)(ws + WS_HB), nullptr, MREAL);
    } else if constexpr (PH == 13) {
        ProbG P; P.K = D; P.S.init(32, 64, F.G, bid); P.A = (const char*)(ws + WS_HB); P.Bt = (const char*)(ws + W1_UP);
        EpiUp E{(bf16_t*)(ws + WS_U1)};
        pg8::gemm_phase<ProbG, EpiUp, true, true>(ring, P, E);
    } else if constexpr (PH == 14) {
        ProbG P; P.K = FF; P.S.init(32, 16, F.G, bid); P.A = (const char*)(ws + WS_U1); P.Bt = (const char*)(ws + W1_DN);
        EpiRes<true> E{ZB2, ZA, ST3, g_m1, b_m1, ST4};
        pg8::gemm_phase<ProbG, EpiRes<true>, true, true>(ring, P, E);
    } else if constexpr (PH == 15) {
        ln_apply(F, ZB2, ST4, g_f1, b_f1, nullptr, args.out, MREAL);
    }
}

__global__ void __launch_bounds__(NWAVES * 64, 2) fwd_kernel(KArgs args) {
    extern __shared__ __attribute__((aligned(16))) unsigned char lds_raw[];
    Frame F;
    F.lds = (LAS unsigned char*)lds_raw;
    F.tid = threadIdx.x; F.lane = F.tid & 63; F.wave = __builtin_amdgcn_readfirstlane(F.tid >> 6);
    F.G = gridDim.x; { const int bx = blockIdx.x; F.vcu = (F.G % 8 == 0) ? (bx % 8) * (F.G / 8) + bx / 8 : bx; }
    volatile LAS unsigned* MISC = (volatile LAS unsigned*)(F.lds + MISC_OFF);
    for (int u = F.tid; u < (LDS_BYTES - LDSCTL_OFF) / 4; u += NWAVES * 64) ((LAS unsigned*)(F.lds + LDSCTL_OFF))[u] = 0u;
    __syncthreads();
    unsigned* ctl = (unsigned*)(args.ws + WS_CTL);
    const int lo = args.ph_lo, hi = args.ph_hi;
    XcdBarrier bar; bar.bar = ctl + CW_BAR + args.li * XCD_BAR_WORDS; bar.x = 0; bar.st = nullptr;
    if (hi - lo > 1 || MK_PROBE_MASK != 0u) bar = xcd_barrier_post(ctl + CW_BAR + args.li * XCD_BAR_WORDS, MISC + 8);
#ifndef ONLY_PHASE
#define ONLY_PHASE -1
#endif
#define IN(k) ((ONLY_PHASE < 0 || ONLY_PHASE == (k)) && lo <= (k) && (k) < hi)
#define PHASE(k) do { if (IN(k)) { run_phase<k>(F, args); if constexpr (((MK_PROBE_MASK) >> (k)) & 1u) { xcd_barrier(bar); run_phase<k>(F, args); } } \
                      if (IN(k) && IN((k) + 1)) xcd_barrier(bar); } while (0)
    PHASE(0); PHASE(1); PHASE(2); PHASE(3); PHASE(4); PHASE(5); PHASE(6); PHASE(7);
    PHASE(8); PHASE(9); PHASE(10); PHASE(11); PHASE(12); PHASE(13); PHASE(14); PHASE(15);
#undef IN
#undef PHASE
}

extern "C" void kernel_launch(void* const* d_in, const int* in_sizes, int n_in, void* d_out, int out_size, void* d_ws, size_t ws_size, hipStream_t stream) {
    static int grid = 0;
    if (grid == 0) {
        if (n_in != 26 || in_sizes[0] != MREAL * D || out_size != MREAL * D || ws_size < WS_END) {
            fprintf(stderr, "kernel_launch: unexpected shapes (n_in %d, in0 %d, out %d, ws %zu, need %zu); nothing launched\n", n_in, n_in > 0 ? in_sizes[0] : -1, out_size, ws_size, (size_t)WS_END); grid = -1; return; }
        int dev = 0, cus = 0, per_cu = 0;
        if (hipGetDevice(&dev) != hipSuccess || hipDeviceGetAttribute(&cus, hipDeviceAttributeMultiprocessorCount, dev) != hipSuccess) { grid = -1; return; }
        if (hipFuncSetAttribute((const void*)fwd_kernel, hipFuncAttributeMaxDynamicSharedMemorySize, LDS_BYTES) != hipSuccess) { fprintf(stderr, "kernel_launch: hipFuncSetAttribute failed\n"); grid = -1; return; }
        if (hipOccupancyMaxActiveBlocksPerMultiprocessor(&per_cu, (const void*)fwd_kernel, NWAVES * 64, LDS_BYTES) != hipSuccess || per_cu < 1)
            fprintf(stderr, "kernel_launch: note: occupancy query reports %d workgroups per CU\n", per_cu);
        (void)hipGetLastError();
        grid = cus;
    }
    if (grid < 0) return;
    if (hipMemsetAsync((char*)d_ws + WS_CTL, 0, CTL_ZERO_BYTES, stream) != hipSuccess) return;
    KArgs a{};
    for (int i = 0; i < 26; ++i) a.in[i] = (const float*)d_in[i];
    a.out = (float*)d_out; a.ws = (unsigned char*)d_ws; a.pad = 0;
#if MK_ONE_LAUNCH
    a.ph_lo = 0; a.ph_hi = N_PHASES; a.li = 0;
    hipLaunchKernelGGL(fwd_kernel, dim3(grid), dim3(NWAVES * 64), LDS_BYTES, stream, a);
#else
    for (int p = 0; p < N_PHASES; ++p) { a.ph_lo = p; a.ph_hi = p + 1; a.li = p;
        hipLaunchKernelGGL(fwd_kernel, dim3(grid), dim3(NWAVES * 64), LDS_BYTES, stream, a); }
#endif
}
```

```cpp
#include <hip/hip_runtime.h>
#include <cstdio>
#include <cstdint>

#define LAS __attribute__((address_space(3)))
#define GAS __attribute__((address_space(1)))
typedef unsigned short bf16_t;
typedef short bf16x8 __attribute__((ext_vector_type(8)));
typedef float f32x2 __attribute__((ext_vector_type(2)));
typedef float f32x4 __attribute__((ext_vector_type(4)));
typedef float f32x16 __attribute__((ext_vector_type(16)));
typedef unsigned u32x2 __attribute__((ext_vector_type(2)));
typedef unsigned u32x4 __attribute__((ext_vector_type(4)));
typedef __bf16 bf16v2 __attribute__((ext_vector_type(2)));

__device__ __forceinline__ unsigned pk2(float lo, float hi) { f32x2 v = {lo, hi}; return __builtin_bit_cast(unsigned, __builtin_convertvector(v, bf16v2)); }
__device__ __forceinline__ float bf_lo(unsigned u) { return __builtin_bit_cast(float, u << 16); }
__device__ __forceinline__ float bf_hi(unsigned u) { return __builtin_bit_cast(float, u & 0xffff0000u); }
__device__ __forceinline__ float fexp2(float x) { return __builtin_amdgcn_exp2f(x); }
__device__ __forceinline__ float flog2(float x) { return __builtin_amdgcn_logf(x); }
__device__ __forceinline__ float fexp(float x) { return __builtin_amdgcn_exp2f(x * 1.44269504089f); }
__device__ __forceinline__ float frcp(float x) { return __builtin_amdgcn_rcpf(x); }
__device__ __forceinline__ float fsigmoid(float x) { return frcp(1.0f + fexp(-x)); }
__device__ __forceinline__ float afma(float a, float b, float c) { float d; asm("v_fma_f32 %0, %1, %2, %3" : "=v"(d) : "v"(a), "v"(b), "v"(c)); return d; }
__device__ __forceinline__ float amul(float a, float b) { float d; asm("v_mul_f32 %0, %1, %2" : "=v"(d) : "v"(a), "v"(b)); return d; }
__device__ __forceinline__ float aadd(float a, float b) { float d; asm("v_add_f32 %0, %1, %2" : "=v"(d) : "v"(a), "v"(b)); return d; }
__device__ __forceinline__ f32x2 pfma2(f32x2 a, f32x2 b, f32x2 c) { return __builtin_elementwise_fma(a, b, c); }
__device__ __forceinline__ float asub(float a, float b) { float d; asm("v_sub_f32 %0, %1, %2" : "=v"(d) : "v"(a), "v"(b)); return d; }

constexpr int D = 4096, NBATCH = 4, TSEQ = 2048, NMETA = 16, FF = 16384;
constexpr int MREAL = NBATCH * TSEQ;
constexpr int MROWS = MREAL + NMETA;
constexpr int RP = 8448;
constexpr int RW_H = 64, RW_N = 64;
constexpr int SB_H = 32, SB_D = 128;
constexpr float LN_EPS = 1e-5f, GN_EPS = 64e-5f;
constexpr float DN_ALPHA = 1.4142135623730951f;
constexpr float QSCALE = 0.08838834764831845f * 1.4426950408889634f;

namespace pg8 {
constexpr int BM = 256, BK = 64, HALF = 128, HTB = HALF * BK * 2, STAGE_BYTES = 8 * HTB, NXCD = 8, WGM = 8;
__host__ __device__ __forceinline__ int lds_byte(int r, int c) { const int st = (r >> 4) * 2 + (c >> 5), rr = r & 15, cc = c & 31, ob = rr * 64 + cc * 2; return st * 1024 + (ob ^ (((ob >> 9) & 1) << 5)); }
__host__ __device__ __forceinline__ void stage_rc(int b, int& R, int& C) { const int st = b / 1024, sb = b % 1024, swz = sb ^ (((sb >> 9) & 1) << 5); R = (st >> 1) * 16 + swz / 64; C = (st & 1) * 32 + (swz % 64) / 2; }
__host__ __device__ __forceinline__ int perm32(int rho) { const int n = rho >> 4, i = rho & 15; return 8 * (i >> 2) + 4 * n + (i & 3); }

struct Unit { int pm, pn; };
struct TileOrder {
    int nM, nN, nwg, G, c, nN2, nwg2;
    __device__ __forceinline__ void init(int nM_, int nN_, int G_, int c_, int nN2_ = 0) { nM = nM_; nN = nN_; nwg = nM * nN; G = G_; c = c_; nN2 = nN2_; nwg2 = nM * nN2_; }
    __device__ __forceinline__ bool next(int i, Unit& u) const {
        const long L = (long)i * G + c; if (L >= nwg + nwg2) return false;
        if (L >= nwg) { const int l2 = (int)L - nwg; u.pm = l2 % nM; u.pn = nN + l2 / nM; return true; }
        int wgid = (int)L; { const int q = nwg / NXCD, r = nwg % NXCD, xcd = wgid % NXCD, off = wgid / NXCD; wgid = (xcd < r ? xcd * (q + 1) : r * (q + 1) + (xcd - r) * q) + off; }
        const int nig = WGM * nN, gid = wgid / nig, fm = gid * WGM, gsz = (nM - fm) < WGM ? (nM - fm) : WGM;
        u.pm = fm + ((wgid % nig) % gsz); u.pn = (wgid % nig) / gsz; return true;
    }
};

template <class Prob, class Epi, bool ALIGN_EPI, bool SP2>
__device__ __forceinline__ void gemm_phase(LAS unsigned char* lds, const Prob& P, const Epi& E) {
    const int tid = threadIdx.x, wid = __builtin_amdgcn_readfirstlane(tid >> 6), lane = tid & 63, wr = wid >> 2, wc = wid & 3, fr = lane & 15, fq = lane >> 4;
    const int K = P.K;
    unsigned voffA[2], voffB[2];
#pragma unroll
    for (int i = 0; i < 2; ++i) { int R, C; stage_rc(tid * 16 + i * 8192, R, C); const int Rb = Epi::PERM ? ((R & ~31) + perm32(R & 31)) : R;
        voffA[i] = (unsigned)(R * K + C) * 2u; voffB[i] = (unsigned)(Rb * K + C) * 2u; }
    const size_t kstep = (size_t)(BK * 2);
    const size_t hstep = (size_t)HALF * K * 2;
    const unsigned ldsw = (unsigned)wid * 1024u;
    const int aoff = lds_byte(wr * 64 + fr, fq * 8), boff = lds_byte(wc * 32 + fr, fq * 8);
#define PG8_SA(b, h) (((b) * 2 + (h)) * HTB)
#define PG8_SB(b, h) ((4 + (b) * 2 + (h)) * HTB)
#define PG8_STAGE(bufoff, gbase, voff) do { _Pragma("unroll") for (int _i = 0; _i < 2; ++_i) \
        __builtin_amdgcn_global_load_lds((const unsigned*)((const char*)(gbase) + (voff)[_i]), (LAS unsigned*)(lds + (bufoff) + ldsw + _i * 8192), 16, 0, 0); } while (0)
#define PG8_LDA(dst, b, h) do { _Pragma("unroll") for (int m = 0; m < 4; ++m) _Pragma("unroll") for (int k = 0; k < 2; ++k) dst[m][k] = *(const LAS bf16x8*)(lds + PG8_SA(b, h) + aoff + m * 2048 + k * 1024); } while (0)
#define PG8_LDB(dst, b, h) do { _Pragma("unroll") for (int n = 0; n < 2; ++n) _Pragma("unroll") for (int k = 0; k < 2; ++k) dst[n][k] = *(const LAS bf16x8*)(lds + PG8_SB(b, h) + boff + n * 2048 + k * 1024); } while (0)
#define PG8_MMA(ai, bj, At, Bt) do { __builtin_amdgcn_s_setprio(1); _Pragma("unroll") for (int m = 0; m < 4; ++m) _Pragma("unroll") for (int n = 0; n < 2; ++n) _Pragma("unroll") for (int k = 0; k < 2; ++k) \
        acc[ai][bj][m][n] = __builtin_amdgcn_mfma_f32_16x16x32_bf16(Bt[n][k], At[m][k], acc[ai][bj][m][n], 0, 0, 0); __builtin_amdgcn_s_setprio(0); } while (0)
#define PG8_WAIT_V(n) asm volatile("s_waitcnt vmcnt(" #n ")" ::: "memory")
#define PG8_WAIT_L(n) asm volatile("s_waitcnt lgkmcnt(" #n ")" ::: "memory")
#define PG8_BAR __builtin_amdgcn_s_barrier()
#define PG8_SCHED __builtin_amdgcn_sched_barrier(0)
    Unit cur, nxt; int ui = 0;
    if (!P.S.next(0, cur)) return;
    f32x4 acc[2][2][4][2];
#pragma unroll
    for (int a = 0; a < 2; ++a)
#pragma unroll
        for (int b = 0; b < 2; ++b)
#pragma unroll
            for (int m = 0; m < 4; ++m)
#pragma unroll
                for (int n = 0; n < 2; ++n) acc[a][b][m][n] = (f32x4){0.f, 0.f, 0.f, 0.f};
    bf16x8 At[4][2], B0[2][2], B1[2][2];
    const char* cA = P.a_base(cur); const char* cB = P.b_base(cur);
    if constexpr (SP2) {
        PG8_STAGE(PG8_SB(0, 0), cB, voffB); PG8_STAGE(PG8_SB(0, 1), cB + hstep, voffB); PG8_STAGE(PG8_SA(0, 0), cA, voffA); PG8_STAGE(PG8_SA(0, 1), cA + hstep, voffA);
        if (wr == 1) PG8_BAR;
        PG8_WAIT_V(2); PG8_BAR;
        PG8_STAGE(PG8_SB(1, 0), cB + kstep, voffB); PG8_STAGE(PG8_SA(1, 0), cA + kstep, voffA); PG8_STAGE(PG8_SB(1, 1), cB + hstep + kstep, voffB);
        PG8_WAIT_V(6); PG8_BAR;
    } else {
        PG8_STAGE(PG8_SB(0, 0), cB, voffB); PG8_STAGE(PG8_SA(0, 0), cA, voffA); PG8_STAGE(PG8_SB(0, 1), cB + hstep, voffB); PG8_STAGE(PG8_SA(0, 1), cA + hstep, voffA);
        if (wr == 1) PG8_BAR;
        PG8_WAIT_V(4); PG8_BAR;
        PG8_STAGE(PG8_SB(1, 0), cB + kstep, voffB); PG8_STAGE(PG8_SA(1, 0), cA + kstep, voffA); PG8_STAGE(PG8_SB(1, 1), cB + hstep + kstep, voffB);
        PG8_WAIT_V(6); PG8_BAR;
    }
    for (;;) {
        const bool has_next = P.S.next(ui + 1, nxt);
        const char* nA = has_next ? P.a_base(nxt) : cA; const char* nB = has_next ? P.b_base(nxt) : cB;
        const int nt = P.nkt(cur);
        for (int t = 0; t < nt; t += 2) {
            const bool last = (t == nt - 2);
            const char* a1 = cA + (size_t)(t + 1) * kstep;
            const char* a2 = last ? nA : cA + (size_t)(t + 2) * kstep; const char* b2 = last ? nB : cB + (size_t)(t + 2) * kstep;
            const char* a3 = a2 + kstep; const char* b3 = b2 + kstep;
            if constexpr (SP2) {
            PG8_LDB(B0, 0, 0); PG8_LDB(B1, 0, 1); PG8_SCHED; PG8_LDA(At, 0, 0); PG8_STAGE(PG8_SA(1, 1), a1 + hstep, voffA);
            PG8_WAIT_V(8); PG8_WAIT_L(0); PG8_BAR; PG8_MMA(0, 0, At, B0); PG8_MMA(0, 1, At, B1); PG8_BAR; PG8_SCHED;
            PG8_LDA(At, 0, 1); PG8_STAGE(PG8_SB(0, 0), b2, voffB); PG8_STAGE(PG8_SB(0, 1), b2 + hstep, voffB); PG8_STAGE(PG8_SA(0, 0), a2, voffA);
            PG8_WAIT_V(8); PG8_WAIT_L(0); PG8_BAR; PG8_MMA(1, 0, At, B0); PG8_MMA(1, 1, At, B1); PG8_BAR; PG8_SCHED;
            PG8_LDB(B0, 1, 0); PG8_LDB(B1, 1, 1); PG8_SCHED; PG8_LDA(At, 1, 0); PG8_STAGE(PG8_SA(0, 1), a2 + hstep, voffA);
            PG8_WAIT_V(8); PG8_WAIT_L(0); PG8_BAR; PG8_MMA(0, 0, At, B0); PG8_MMA(0, 1, At, B1); PG8_BAR; PG8_SCHED;
            PG8_LDA(At, 1, 1); PG8_STAGE(PG8_SB(1, 0), b3, voffB); PG8_STAGE(PG8_SB(1, 1), b3 + hstep, voffB); PG8_STAGE(PG8_SA(1, 0), a3, voffA);
            PG8_WAIT_V(8); PG8_WAIT_L(0); PG8_BAR; PG8_MMA(1, 0, At, B0); PG8_MMA(1, 1, At, B1); PG8_BAR; PG8_SCHED;
            } else {
            PG8_LDB(B0, 0, 0); PG8_SCHED; PG8_LDA(At, 0, 0); PG8_STAGE(PG8_SA(1, 1), a1 + hstep, voffA);
            PG8_WAIT_L(8); PG8_BAR; PG8_WAIT_L(0); PG8_MMA(0, 0, At, B0); PG8_BAR; PG8_SCHED;
            PG8_LDB(B1, 0, 1); PG8_STAGE(PG8_SB(0, 0), b2, voffB);
            PG8_BAR; PG8_WAIT_L(0); PG8_MMA(0, 1, At, B1); PG8_BAR;
            PG8_LDA(At, 0, 1); PG8_STAGE(PG8_SA(0, 0), a2, voffA);
            PG8_BAR; PG8_WAIT_L(0); PG8_MMA(1, 0, At, B0); PG8_BAR; PG8_SCHED;
            PG8_STAGE(PG8_SB(0, 1), b2 + hstep, voffB);
            PG8_WAIT_V(6); PG8_BAR; PG8_MMA(1, 1, At, B1); PG8_BAR;
            PG8_LDB(B0, 1, 0); PG8_SCHED; PG8_LDA(At, 1, 0); PG8_STAGE(PG8_SA(0, 1), a2 + hstep, voffA);
            PG8_WAIT_L(8); PG8_BAR; PG8_WAIT_L(0); PG8_MMA(0, 0, At, B0); PG8_BAR; PG8_SCHED;
            PG8_LDB(B1, 1, 1); PG8_STAGE(PG8_SB(1, 0), b3, voffB);
            PG8_BAR; PG8_WAIT_L(0); PG8_MMA(0, 1, At, B1); PG8_BAR;
            PG8_LDA(At, 1, 1); PG8_STAGE(PG8_SA(1, 0), a3, voffA);
            PG8_BAR; PG8_WAIT_L(0); PG8_MMA(1, 0, At, B0); PG8_BAR; PG8_SCHED;
            PG8_STAGE(PG8_SB(1, 1), b3 + hstep, voffB);
            PG8_WAIT_V(6); PG8_BAR; PG8_MMA(1, 1, At, B1); PG8_BAR;
            }
        }
        if constexpr (ALIGN_EPI) { if (wr == 0) PG8_BAR; }
        E(acc, cur, wr, wc, fr, fq);
        if (!has_next) break;
#pragma unroll
        for (int a = 0; a < 2; ++a)
#pragma unroll
            for (int b = 0; b < 2; ++b)
#pragma unroll
                for (int m = 0; m < 4; ++m)
#pragma unroll
                    for (int n = 0; n < 2; ++n) acc[a][b][m][n] = (f32x4){0.f, 0.f, 0.f, 0.f};
        cur = nxt; cA = nA; cB = nB; ++ui;
        if constexpr (ALIGN_EPI) { if (wr == 1) PG8_BAR; }
    }
    PG8_WAIT_V(0);
    if constexpr (!ALIGN_EPI) { if (wr == 0) PG8_BAR; }
    PG8_BAR;
#undef PG8_SA
#undef PG8_SB
#undef PG8_STAGE
#undef PG8_LDA
#undef PG8_LDB
#undef PG8_MMA
#undef PG8_WAIT_V
#undef PG8_WAIT_L
#undef PG8_BAR
#undef PG8_SCHED
}
}
using pg8::Unit;

constexpr size_t MiB = (size_t)1 << 20;
constexpr size_t WS_CTL = 0, CTL_ZERO_BYTES = 1 * MiB;
constexpr size_t WS_W = 1 * MiB;
constexpr size_t W0_CAT = WS_W;
constexpr size_t W0_L2 = W0_CAT + 104 * MiB;
constexpr size_t W0_O = W0_L2 + 12 * MiB;
constexpr size_t W0_UP = W0_O + 32 * MiB;
constexpr size_t W0_DN = W0_UP + 128 * MiB;
constexpr size_t WS_X = WS_W + 404 * MiB;
constexpr size_t W1_QKV = WS_X;
constexpr size_t W1_O = W1_QKV + 96 * MiB;
constexpr size_t W1_UP = W1_O + 32 * MiB;
constexpr size_t W1_DN = W1_UP + 128 * MiB;
constexpr size_t ACT_BF = (size_t)RP * D * 2;
constexpr size_t ACT_F32 = (size_t)RP * D * 4;
constexpr size_t WS_Y = WS_X + 396 * MiB;
constexpr size_t WS_ZB = WS_Y, WS_HF = WS_Y + 132 * MiB, WS_HB = WS_Y + 264 * MiB;
constexpr size_t WS_Z = WS_Y + 396 * MiB;
constexpr size_t WS_L1O = WS_Z;
constexpr size_t L1O_BYTES = (size_t)3 * RP * 512 * 2;
constexpr size_t WS_WDEC = WS_Z + 25 * MiB, WS_AA = WS_WDEC + 132 * MiB, WS_GG = WS_AA + 132 * MiB, WS_YG = WS_GG + 66 * MiB;
constexpr size_t WS_QB = WS_Z, WS_KB = WS_Z + 66 * MiB, WS_VB = WS_Z + 132 * MiB, WS_OB = WS_Z + 198 * MiB;
constexpr size_t WS_U0 = WS_Z;
constexpr size_t WS_U1 = WS_W;
constexpr size_t WS_END = WS_Z + 421 * MiB;
static_assert(W1_DN + 128 * MiB <= WS_X + 396 * MiB && (size_t)RP * FF * 2 <= 404 * MiB && (size_t)RP * FF * 2 <= 421 * MiB && L1O_BYTES <= 25 * MiB && WS_YG + ACT_BF <= WS_END && W0_DN + 128 * MiB <= WS_X && 6 * ACT_BF <= 396 * MiB && 3 * ACT_F32 <= 396 * MiB, "ws map");
constexpr int CW_TMO = 0;
constexpr int CW_BAR = 4096;
constexpr size_t CTL_STATS = 512 * 1024;
constexpr size_t STATS_BYTES = (size_t)RP * 2 * 4;
static_assert(CTL_STATS + 4 * STATS_BYTES <= CTL_ZERO_BYTES, "stats inside the per-call memset");

constexpr int NWAVES = 8;
constexpr int RING_BYTES = 131072;
constexpr int LDSCTL_OFF = 139264, MISC_OFF = LDSCTL_OFF + 320;
constexpr int LDS_BYTES = 147456;

#define XB_TMO      128
#define XB_XCNT(j)  (256  + 64 * (j))
#define XB_XSUB(j)  (1280 + 64 * (j))
#define XB_XGEN(j)  (2304 + 64 * (j))
#define XB_TOP      3328
#define XB_TOPGEN   3392
#define XCD_BAR_WORDS 3456
#define XB_SPIN_CAP (1u << 18)
__device__ __forceinline__ unsigned xb_ld(unsigned* p)              { return __hip_atomic_load(p, __ATOMIC_RELAXED, __HIP_MEMORY_SCOPE_AGENT); }
__device__ __forceinline__ unsigned xb_add(unsigned* p, unsigned v) { return __hip_atomic_fetch_add(p, v, __ATOMIC_RELAXED, __HIP_MEMORY_SCOPE_AGENT); }
__device__ __forceinline__ unsigned xb_xcc_id() { return (unsigned)__builtin_amdgcn_s_getreg((3 << 11) | 20) & 0xFu; }
#define XB_SPIN(cond, bar) do { unsigned _sp = 0; while (cond) { __builtin_amdgcn_s_sleep(1); \
    if ((++_sp & 255u) == 0u) { if (xb_ld(&(bar)[XB_TMO])) break; if (_sp > XB_SPIN_CAP) { atomicAdd(&(bar)[XB_TMO], 1u); break; } } } } while (0)
struct XcdBarrier { unsigned* bar; unsigned x; volatile LAS unsigned* st; };
__device__ __forceinline__ XcdBarrier xcd_barrier_post(unsigned* bar, volatile LAS unsigned* st) {
    XcdBarrier b; b.bar = bar; b.x = xb_xcc_id(); b.st = st;
    if (threadIdx.x == 0) (void)xb_add(&bar[XB_XCNT(b.x)], 1u);
    return b;
}
__device__ __forceinline__ void xcd_barrier_complete(unsigned* bar, unsigned x, unsigned& nloc, unsigned& nx) {
    const unsigned G = gridDim.x * gridDim.y * gridDim.z;
    unsigned sum, cnt, mine, sp = 0u;
    for (;;) {
        sum = 0u; cnt = 0u; mine = 0u;
#pragma unroll
        for (unsigned j = 0; j < 16; ++j) { const unsigned c = xb_ld(&bar[XB_XCNT(j)]); sum += c; cnt += (c > 0u) ? 1u : 0u; mine = (j == x) ? c : mine; }
        if (sum == G) break;
        __builtin_amdgcn_s_sleep(1);
        if ((++sp & 255u) == 0u) { if (xb_ld(&bar[XB_TMO])) break; if (sp > XB_SPIN_CAP) { atomicAdd(&bar[XB_TMO], 1u); break; } }
    }
    nloc = mine > 0u ? mine : 1u; nx = cnt > 0u ? cnt : 1u;
}
__device__ __forceinline__ void xcd_barrier(const XcdBarrier& b) {
    asm volatile("s_waitcnt vmcnt(0)" ::: "memory");
    __syncthreads();
    if (threadIdx.x == 0) {
        unsigned* bar = b.bar;
        __builtin_amdgcn_s_waitcnt(0);
        unsigned nloc = b.st[0], nx = b.st[1];
        if (nloc == 0u) { xcd_barrier_complete(bar, b.x, nloc, nx); b.st[0] = nloc; b.st[1] = nx; }
        const unsigned old = xb_add(&bar[XB_XSUB(b.x)], 1u);
        const unsigned gen = old / nloc;
        if (old + 1u == (gen + 1u) * nloc) {
            __builtin_amdgcn_fence(__ATOMIC_RELEASE, "agent");
            asm volatile("s_waitcnt vmcnt(0)" ::: "memory");
            const unsigned og = xb_add(&bar[XB_TOP], 1u);
            const unsigned tg = og / nx;
            if (og + 1u == (tg + 1u) * nx) xb_add(&bar[XB_TOPGEN], 1u);
            else XB_SPIN(xb_ld(&bar[XB_TOPGEN]) == tg, bar);
            __builtin_amdgcn_fence(__ATOMIC_ACQUIRE, "agent");
            xb_add(&bar[XB_XGEN(b.x)], 1u);
            asm volatile("s_waitcnt vmcnt(0)" ::: "memory");
        } else {
            XB_SPIN(xb_ld(&bar[XB_XGEN(b.x)]) == gen, bar);
            __builtin_amdgcn_fence(__ATOMIC_ACQUIRE, "agent");
            asm volatile("s_waitcnt vmcnt(0)" ::: "memory");
        }
    }
    __syncthreads();
}

struct Params { const float* in[26]; float* out; unsigned char* ws; int ph_lo, ph_hi; };
enum { I_X = 0, I_META, I_LNMG, I_LNMB, I_LNFG, I_LNFB, I_WUP, I_WDN, I_MU, I_WRKV, I_W0, I_W1, I_W2, I_A0, I_A1, I_A2, I_G1, I_G2, I_KK, I_KA, I_RK, I_GNG, I_GNB, I_RWO, I_SBQKV, I_SBO };

struct Frame {
    LAS unsigned char* lds;
    int tid, lane, wave, vcu, G;
};
__device__ __forceinline__ float red16(float x) {
    x += __builtin_bit_cast(float, __builtin_amdgcn_update_dpp(0, __builtin_bit_cast(int, x), 0xB1, 0xF, 0xF, true));
    x += __builtin_bit_cast(float, __builtin_amdgcn_update_dpp(0, __builtin_bit_cast(int, x), 0x4E, 0xF, 0xF, true));
    x += __builtin_bit_cast(float, __builtin_amdgcn_update_dpp(0, __builtin_bit_cast(int, x), 0x141, 0xF, 0xF, true));
    x += __builtin_bit_cast(float, __builtin_amdgcn_update_dpp(0, __builtin_bit_cast(int, x), 0x140, 0xF, 0xF, true));
    return x;
}
template <int CTRL> __device__ __forceinline__ float dpp_mov(float v) { return __builtin_bit_cast(float, __builtin_amdgcn_update_dpp(0, __builtin_bit_cast(int, v), CTRL, 0xF, 0xF, true)); }
template <int CTRL> __device__ __forceinline__ f32x4 dpp_stage4(f32x4 x) { f32x4 t; t[0] = dpp_mov<CTRL>(x[0]); t[1] = dpp_mov<CTRL>(x[1]); t[2] = dpp_mov<CTRL>(x[2]); t[3] = dpp_mov<CTRL>(x[3]); return x + t; }
__device__ __forceinline__ f32x4 red16x4(f32x4 x) {
    float a = x[0], b = x[1], c = x[2], d = x[3];
#define R16_ROW(mod) "v_add_f32_dpp %0, %0, %0 " mod " row_mask:0xf bank_mask:0xf bound_ctrl:1\n\tv_add_f32_dpp %1, %1, %1 " mod " row_mask:0xf bank_mask:0xf bound_ctrl:1\n\t" \
                     "v_add_f32_dpp %2, %2, %2 " mod " row_mask:0xf bank_mask:0xf bound_ctrl:1\n\tv_add_f32_dpp %3, %3, %3 " mod " row_mask:0xf bank_mask:0xf bound_ctrl:1\n\t"
    asm volatile("s_nop 1\n\t" R16_ROW("quad_perm:[1,0,3,2]") R16_ROW("quad_perm:[2,3,0,1]") R16_ROW("row_half_mirror") R16_ROW("row_mirror") : "+v"(a), "+v"(b), "+v"(c), "+v"(d));
#undef R16_ROW
    return (f32x4){a, b, c, d};
}
__device__ __forceinline__ float wave_sum(float v) {
#pragma unroll
    for (int o = 1; o < 64; o <<= 1) v += __shfl_xor(v, o);
    return v;
}

__device__ __forceinline__ size_t hm_off(int row, int col) { return ((size_t)((row >> 11) * 64 + (col >> 6)) << 17) + (size_t)((row & 2047) * 64 + (col & 63)); }
__device__ __forceinline__ size_t hm_off_meta(int m, int col) { return (size_t)MREAL * D + (size_t)(((col >> 6) * 16 + m) * 64 + (col & 63)); }
struct ProbP1 {
    int K; pg8::TileOrder S; const char* mixed; const char* wcat;
    __device__ __forceinline__ const char* a_base(const Unit& u) const { const int gi = u.pn < 44 ? (u.pn >> 4) : (u.pn >= 48 ? 2 : (u.pn == 44 ? 3 : (u.pn == 45 ? 4 : 5)));
        return mixed + (size_t)gi * ACT_BF + (size_t)u.pm * 256 * D * 2 + (u.pn >= 48 ? (size_t)((u.pn - 48) & 1) * 4096 : (size_t)0); }
    __device__ __forceinline__ const char* b_base(const Unit& u) const { const int wt = u.pn < 44 ? u.pn : (u.pn < 48 ? u.pn + 4 : 44 + ((u.pn - 48) >> 1));
        return wcat + (size_t)wt * 256 * D * 2 + (u.pn >= 48 ? (size_t)((u.pn - 48) & 1) * 4096 : (size_t)0); }
    __device__ __forceinline__ int nkt(const Unit& u) const { return u.pn < 48 ? 64 : 32; }
};
struct EpiP1 {
    static constexpr bool PERM = false;
    bf16_t* rkv; bf16_t* l1o;
    __device__ __forceinline__ void operator()(const f32x4 (&acc)[2][2][4][2], const Unit& u, int wr, int wc, int fr, int fq) const {
        const int row0 = u.pm * 256 + wr * 64 + fr, c0 = wc * 32 + 4 * fq;
        if (u.pn < 44 || u.pn >= 48) {
            const int sub = u.pn < 44 ? (u.pn >> 4) : 2 + ((u.pn - 48) & 1), ct = u.pn < 44 ? (u.pn & 15) : 12 + ((u.pn - 48) >> 1);
            bf16_t* C = rkv + (size_t)sub * RP * D + hm_off(row0, ct * 256 + c0);
#pragma unroll
            for (int ai = 0; ai < 2; ++ai)
#pragma unroll
                for (int m = 0; m < 4; ++m) {
#pragma unroll
                    for (int bj = 0; bj < 2; ++bj)
#pragma unroll
                        for (int n = 0; n < 2; ++n) { const f32x4 v = acc[ai][bj][m][n]; u32x2 w; w.x = pk2(v[0], v[1]); w.y = pk2(v[2], v[3]); *(u32x2*)(C + (size_t)((ai * 128 + m * 16) * 64 + bj * (2 << 17) + n * 16)) = w; } }
        } else {
            const int lt = u.pn - 44, sub = lt < 2 ? lt : 2;
            bf16_t* O = l1o + (size_t)sub * RP * 512 + (lt == 3 ? 256 : 0) + c0;
#pragma unroll
            for (int ai = 0; ai < 2; ++ai)
#pragma unroll
                for (int m = 0; m < 4; ++m) { bf16_t* rowp = O + (size_t)(row0 + ai * 128 + m * 16) * 512;
#pragma unroll
                    for (int bj = 0; bj < 2; ++bj)
#pragma unroll
                        for (int n = 0; n < 2; ++n) { f32x4 v = acc[ai][bj][m][n];
                            if (sub == 0) {
#pragma unroll
                                for (int j = 0; j < 4; ++j) v[j] = 1.0f - 2.0f * frcp(fexp(2.0f * v[j]) + 1.0f);
                            } else if (sub == 2) {
#pragma unroll
                                for (int j = 0; j < 4; ++j) v[j] = fsigmoid(v[j]);
                            }
                            u32x2 w; w.x = pk2(v[0], v[1]); w.y = pk2(v[2], v[3]); *(u32x2*)(rowp + bj * 128 + n * 16) = w; } }
        }
    }
};
struct ProbL2 {
    int K; pg8::TileOrder S; const char* l1o; const char* w2;
    __device__ __forceinline__ const char* a_base(const Unit& u) const { return l1o + (size_t)(u.pn >> 4) * RP * 512 * 2 + (size_t)u.pm * 256 * 512 * 2; }
    __device__ __forceinline__ const char* b_base(const Unit& u) const { return w2 + (size_t)u.pn * 256 * 512 * 2; }
    __device__ __forceinline__ int nkt(const Unit& u) const { return (u.pn >> 4) < 2 ? 2 : 8; }
};
struct EpiL2 {
    static constexpr bool PERM = false;
    bf16_t* wdec; bf16_t* aa; bf16_t* gg; const float* w0; const float* a0;
    __device__ __forceinline__ void operator()(const f32x4 (&acc)[2][2][4][2], const Unit& u, int wr, int wc, int fr, int fq) const {
        const int row0 = u.pm * 256 + wr * 64 + fr, col0 = (u.pn & 15) * 256 + wc * 32 + 4 * fq, sub = u.pn >> 4;
        const size_t hbase = hm_off(row0, col0);
#pragma unroll
        for (int bj = 0; bj < 2; ++bj)
#pragma unroll
            for (int n = 0; n < 2; ++n) { const int col = col0 + bj * 128 + n * 16;
                f32x4 bias = (f32x4){0.f, 0.f, 0.f, 0.f};
                if (sub == 0) bias = *(const f32x4*)(w0 + col); else if (sub == 1) bias = *(const f32x4*)(a0 + col);
#pragma unroll
                for (int ai = 0; ai < 2; ++ai)
#pragma unroll
                    for (int m = 0; m < 4; ++m) { const size_t off = hbase + (size_t)((ai * 128 + m * 16) * 64 + bj * (2 << 17) + n * 16);
                        f32x4 v = acc[ai][bj][m][n] + bias;
                        if (sub == 0) {
#pragma unroll
                            for (int j = 0; j < 4; ++j) v[j] = 1.0f - fexp(-0.60653065971f * fsigmoid(v[j]));
                            { u32x2 w; w.x = pk2(v[0], v[1]); w.y = pk2(v[2], v[3]); *(u32x2*)(wdec + off) = w; }
                        } else if (sub == 1) {
#pragma unroll
                            for (int j = 0; j < 4; ++j) v[j] = fsigmoid(v[j]);
                            { u32x2 w; w.x = pk2(v[0], v[1]); w.y = pk2(v[2], v[3]); *(u32x2*)(aa + off) = w; }
                        } else { u32x2 w; w.x = pk2(v[0], v[1]); w.y = pk2(v[2], v[3]); *(u32x2*)(gg + off) = w; } } }
    }
};
struct ProbG {
    int K; pg8::TileOrder S; const char* A; const char* Bt;
    __device__ __forceinline__ const char* a_base(const Unit& u) const { return A + (size_t)u.pm * 256 * K * 2; }
    __device__ __forceinline__ const char* b_base(const Unit& u) const { return Bt + (size_t)u.pn * 256 * K * 2; }
    __device__ __forceinline__ int nkt(const Unit&) const { return K / 64; }
};
struct ProbQkv {
    int K; pg8::TileOrder S; const char* hb; const char* w;
    __device__ __forceinline__ const char* a_base(const Unit& u) const { return u.pn < 32 ? hb + (size_t)u.pm * 256 * D * 2 : w + (size_t)(8192 + (u.pn - 32) * 256) * D * 2; }
    __device__ __forceinline__ const char* b_base(const Unit& u) const { return u.pn < 32 ? w + (size_t)u.pn * 256 * D * 2 : hb + (size_t)u.pm * 256 * D * 2; }
    __device__ __forceinline__ int nkt(const Unit&) const { return D / 64; }
};
__device__ __forceinline__ void ln_row_stats(const float* st, int row, float& rho, float& nmr) {
    const float s1 = st[2 * row], s2 = st[2 * row + 1];
    const float mean = s1 * (1.0f / D), var = fmaxf(s2 * (1.0f / D) - mean * mean, 0.f);
    rho = __builtin_amdgcn_rsqf(var + LN_EPS); nmr = -mean * rho;
}
template <bool LNRES> struct EpiRes {
    static constexpr bool PERM = false;
    float* z; const float* res; const float* st_in; const float* g; const float* b; float* st_out;
    __device__ __forceinline__ void operator()(const f32x4 (&acc)[2][2][4][2], const Unit& u, int wr, int wc, int fr, int fq) const {
        const int row0 = u.pm * 256 + wr * 64 + fr, col0 = u.pn * 256 + wc * 32 + 4 * fq;
        f32x4 gv[2][2], bv[2][2];
        if (LNRES) {
#pragma unroll
            for (int bj = 0; bj < 2; ++bj)
#pragma unroll
                for (int n = 0; n < 2; ++n) { gv[bj][n] = *(const f32x4*)(g + col0 + bj * 128 + n * 16); bv[bj][n] = *(const f32x4*)(b + col0 + bj * 128 + n * 16); }
        }
#pragma unroll
        for (int ai = 0; ai < 2; ++ai)
#pragma unroll
            for (int m = 0; m < 4; ++m) { const int row = row0 + ai * 128 + m * 16;
                const float* rp = res + (size_t)row * D + col0;
                float* zp = z + (size_t)row * D + col0;
                float rho = 1.f, nmr = 0.f;
                if (LNRES) ln_row_stats(st_in, row, rho, nmr);
                float s1 = 0.f, s2 = 0.f;
#pragma unroll
                for (int bj = 0; bj < 2; ++bj)
#pragma unroll
                    for (int n = 0; n < 2; ++n) { f32x4 r = *(const f32x4*)(rp + bj * 128 + n * 16);
                        if (LNRES) r = (r * rho + nmr) * gv[bj][n] + bv[bj][n];
                        const f32x4 zz = r * DN_ALPHA + acc[ai][bj][m][n];
                        *(f32x4*)(zp + bj * 128 + n * 16) = zz;
                        s1 += (zz[0] + zz[1]) + (zz[2] + zz[3]); s2 += (zz[0] * zz[0] + zz[1] * zz[1]) + (zz[2] * zz[2] + zz[3] * zz[3]); }
                s1 += __shfl_xor(s1, 16); s2 += __shfl_xor(s2, 16); s1 += __shfl_xor(s1, 32); s2 += __shfl_xor(s2, 32);
                if (fq == 0) { atomicAdd(st_out + 2 * row, s1); atomicAdd(st_out + 2 * row + 1, s2); } }
    }
};
struct EpiUp {
    static constexpr bool PERM = true;
    bf16_t* O;
    __device__ __forceinline__ void operator()(const f32x4 (&acc)[2][2][4][2], const Unit& u, int wr, int wc, int fr, int fq) const {
        const int row0 = u.pm * 256 + wr * 64 + fr, col0 = u.pn * 256 + wc * 32 + 8 * fq;
#pragma unroll
        for (int ai = 0; ai < 2; ++ai)
#pragma unroll
            for (int m = 0; m < 4; ++m) { bf16_t* rowp = O + (size_t)(row0 + ai * 128 + m * 16) * FF + col0;
#pragma unroll
                for (int bj = 0; bj < 2; ++bj) { f32x4 v0 = acc[ai][bj][m][0], v1 = acc[ai][bj][m][1];
#pragma unroll
                    for (int j = 0; j < 4; ++j) { const float a = fmaxf(v0[j], 0.f), b = fmaxf(v1[j], 0.f); v0[j] = a * a; v1[j] = b * b; }
                    u32x4 w; w.x = pk2(v0[0], v0[1]); w.y = pk2(v0[2], v0[3]); w.z = pk2(v1[0], v1[1]); w.w = pk2(v1[2], v1[3]);
                    *(u32x4*)(rowp + bj * 128) = w; } }
    }
};
struct EpiQkv {
    static constexpr bool PERM = true;
    bf16_t* qb;
    __device__ __forceinline__ void operator()(const f32x4 (&acc)[2][2][4][2], const Unit& u, int wr, int wc, int fr, int fq) const {
        const int t = u.pn >> 4; const float sc = (t == 0) ? QSCALE : 1.0f;
        bf16_t* O; size_t ld;
        if (t < 2) { O = qb + (size_t)t * RP * D + (size_t)(u.pm * 256) * D + (u.pn & 15) * 256; ld = D; }
        else { O = qb + (size_t)2 * RP * D + (size_t)((u.pn - 32) * 256) * RP + u.pm * 256; ld = RP; }
        O += (size_t)(wr * 64 + fr) * ld + wc * 32 + 8 * fq;
#pragma unroll
        for (int ai = 0; ai < 2; ++ai)
#pragma unroll
            for (int m = 0; m < 4; ++m) { bf16_t* rowp = O + (size_t)(ai * 128 + m * 16) * ld;
#pragma unroll
                for (int bj = 0; bj < 2; ++bj) { const f32x4 v0 = acc[ai][bj][m][0] * sc, v1 = acc[ai][bj][m][1] * sc;
                    u32x4 w; w.x = pk2(v0[0], v0[1]); w.y = pk2(v0[2], v0[3]); w.z = pk2(v1[0], v1[1]); w.w = pk2(v1[2], v1[3]);
                    *(u32x4*)(rowp + bj * 128) = w; } }
    }
};

__device__ __forceinline__ void tr_item(const float* W, int K, int N, int nblk, bf16_t* WT, int Kp, LAS float* scr, int item, int lane) {
    const int kb = item / nblk, nb = item - kb * nblk, k0 = 64 * kb, n0 = 32 * nb;
    const int lr = lane >> 3, lc = (lane & 7) * 4;
    f32x4 v[8];
#pragma unroll
    for (int i = 0; i < 8; ++i) { const int k = k0 + lr + 8 * i, n = n0 + lc; v[i] = (k < K && n < N) ? *(const f32x4*)(W + (size_t)k * N + n) : (f32x4){0.f, 0.f, 0.f, 0.f}; }
#pragma unroll
    for (int i = 0; i < 8; ++i) { LAS float* s = scr + (lr + 8 * i) * 33 + lc; s[0] = v[i].x; s[1] = v[i].y; s[2] = v[i].z; s[3] = v[i].w; }
    asm volatile("s_waitcnt lgkmcnt(0)" ::: "memory");
    const int c = lane & 7;
#pragma unroll
    for (int j = 0; j < 4; ++j) { const int n = (lane >> 3) + 8 * j; const LAS float* s = scr + (8 * c) * 33 + n;
        u32x4 o; o.x = pk2(s[0], s[33]); o.y = pk2(s[66], s[99]); o.z = pk2(s[132], s[165]); o.w = pk2(s[198], s[231]);
        *(u32x4*)(WT + (size_t)(n0 + n) * Kp + k0 + 8 * c) = o; }
    asm volatile("s_waitcnt lgkmcnt(0)" ::: "memory");
}
struct TrJob { const float* W; int K, N, Kp, Np; bf16_t* WT; };
template <int NJ> __device__ __forceinline__ int tr_total(const TrJob (&J)[NJ]) { int t = 0;
#pragma unroll
    for (int j = 0; j < NJ; ++j) t += (J[j].Kp / 64) * (J[j].Np / 32);
    return t; }
template <int NJ> __device__ __forceinline__ void tr_jobs(const Frame& F, const TrJob (&J)[NJ]) {
    LAS float* scr = (LAS float*)(F.lds + F.wave * 8448);
    const int gw = F.vcu * NWAVES + F.wave, NGW = F.G * NWAVES;
    const int total = tr_total<NJ>(J);
    for (int it = gw; it < total; it += NGW) {
        int r = it;
#pragma unroll
        for (int j = 0; j < NJ; ++j) { const int n = (J[j].Kp / 64) * (J[j].Np / 32);
            if (r >= 0 && r < n) tr_item(J[j].W, J[j].K, J[j].N, J[j].Np / 32, J[j].WT, J[j].Kp, scr, r, F.lane);
            r -= n; }
    }
}
struct TrRef { const float* W; bf16_t* WT; int N, Kp; };
template <int NJ> __device__ __forceinline__ TrRef tr_lookup(const TrJob (&J)[NJ], int it) {
    TrRef R; R.W = J[0].W; R.WT = J[0].WT; R.N = 32; R.Kp = 64;
    int r = it;
#pragma unroll
    for (int j = 0; j < NJ; ++j) { const int nblk = J[j].Np / 32, n = (J[j].Kp / 64) * nblk;
        if (r >= 0 && r < n) { const int kb = r / nblk, nb = r - kb * nblk; R.N = J[j].N; R.Kp = J[j].Kp;
            R.W = J[j].W + (size_t)(64 * kb) * J[j].N + 32 * nb; R.WT = J[j].WT + (size_t)(32 * nb) * J[j].Kp + 64 * kb; }
        r -= n; }
    return R;
}
__device__ __forceinline__ void tr_load(const TrRef& R, int lane, f32x4 (&v)[8]) {
    const unsigned off = (unsigned)((2 * (lane >> 3)) * R.N + 4 * (lane & 7));
#pragma unroll
    for (int i = 0; i < 4; ++i) { const float* p = R.W + (size_t)(16 * i) * R.N; v[2 * i] = __builtin_nontemporal_load((const f32x4*)(p + off)); v[2 * i + 1] = __builtin_nontemporal_load((const f32x4*)(p + R.N + off)); }
}
__device__ __forceinline__ void tr_store(const TrRef& R, int lane, const f32x4 (&v)[8], LAS unsigned* scr) {
    const int lr = lane >> 3, lc = 4 * (lane & 7);
#pragma unroll
    for (int i = 0; i < 4; ++i)
#pragma unroll
        for (int q = 0; q < 4; ++q) scr[(lc + q) * 36 + 8 * i + lr] = pk2(v[2 * i][q], v[2 * i + 1][q]);
    asm volatile("s_waitcnt lgkmcnt(0)" ::: "memory");
    const unsigned off = (unsigned)((lane >> 3) * R.Kp + 8 * (lane & 7));
#pragma unroll
    for (int j = 0; j < 4; ++j) { const u32x4 o = *(const LAS u32x4*)(scr + ((lane >> 3) + 8 * j) * 36 + 4 * (lane & 7)); *(u32x4*)(R.WT + (size_t)(8 * j) * R.Kp + off) = o; }
    asm volatile("s_waitcnt lgkmcnt(0)" ::: "memory");
}
__device__ __forceinline__ void mix_phase(const Frame& F, const float* x, const float* meta, const float* mu, bf16_t* mixed) {
    const int gw = F.vcu * NWAVES + F.wave, NGW = F.G * NWAVES;
    for (int task = gw; task < 16 * 257; task += NGW) {
        const int cc = task & 15, rr = task >> 4, col = cc * 256 + F.lane * 4;
        const int row0 = rr < 256 ? rr * 32 : MREAL, nrows = rr < 256 ? 32 : NMETA;
        f32x4 m4[6];
#pragma unroll
        for (int n = 0; n < 6; ++n) m4[n] = *(const f32x4*)(mu + (size_t)n * D + col);
        f32x4 prev = (f32x4){0.f, 0.f, 0.f, 0.f};
        if (rr < 256) prev = ((row0 & (TSEQ - 1)) == 0) ? *(const f32x4*)(meta + (size_t)(NMETA - 1) * D + col) : *(const f32x4*)(x + (size_t)(row0 - 1) * D + col);
        const float* src = rr < 256 ? x + (size_t)row0 * D + col : meta + col;
#pragma unroll 4
        for (int i = 0; i < nrows; ++i) {
            const f32x4 h = *(const f32x4*)(src + (size_t)i * D);
            const f32x4 xx = prev - h;
#pragma unroll
            for (int n = 0; n < 6; ++n) { const f32x4 m = h + xx * m4[n]; u32x2 w; w.x = pk2(m[0], m[1]); w.y = pk2(m[2], m[3]);
                *(u32x2*)(mixed + (size_t)n * RP * D + (size_t)(row0 + i) * D + col) = w; }
            prev = h;
        }
    }
}
__device__ __forceinline__ void zero_bytes(const Frame& F, unsigned char* p, size_t nbytes) {
    const size_t n16 = nbytes / 16, stride = (size_t)F.G * NWAVES * 64;
    for (size_t i = (size_t)(F.vcu * NWAVES + F.wave) * 64 + F.lane; i < n16; i += stride) ((u32x4*)p)[i] = (u32x4){0u, 0u, 0u, 0u};
}
__device__ __forceinline__ void ln_apply(const Frame& F, const float* z, const float* st, const float* g, const float* b, bf16_t* hb, float* out, int nrows) {
    const int gw = F.vcu * NWAVES + F.wave, NGW = F.G * NWAVES;
    for (int row = gw; row < nrows; row += NGW) {
        float rho, nmr; ln_row_stats(st, row, rho, nmr);
        const f32x4* zr = (const f32x4*)(z + (size_t)row * D) + F.lane;
        f32x4 v[16];
#pragma unroll
        for (int j = 0; j < 16; ++j) v[j] = zr[64 * j];
#pragma unroll
        for (int j = 0; j < 16; ++j) { const int col = (64 * j + F.lane) * 4;
            const f32x4 o = (v[j] * rho + nmr) * *(const f32x4*)(g + col) + *(const f32x4*)(b + col);
            if (out) *(f32x4*)(out + (size_t)row * D + col) = o;
            if (hb) { u32x2 w; w.x = pk2(o[0], o[1]); w.y = pk2(o[2], o[3]); *(u32x2*)(hb + (size_t)row * D + col) = w; } }
    }
}
template <int STEPS, class SP> __device__ __forceinline__ void skinny_gemm(const Frame& F, int K, int ntiles, const SP& P) {
    LAS float* PS = (LAS float*)F.lds;
    const int lane = F.lane, r = lane & 15, kq = lane >> 4, kw = K >> 3;
    for (int t = F.vcu; t < ntiles; t += F.G) {
        const bf16_t* A; const bf16_t* B; int lda;
        P.tile(t, A, lda, B);
        const bf16_t* ap = A + (size_t)r * lda + F.wave * kw + kq * 8;
        const bf16_t* bp = B + (size_t)r * K + F.wave * kw + kq * 8;
        f32x4 acc = (f32x4){0.f, 0.f, 0.f, 0.f};
        for (int i0 = 0; i0 < kw; i0 += 32 * STEPS) {
            bf16x8 a[STEPS], b[STEPS];
#pragma unroll
            for (int i = 0; i < STEPS; ++i) { a[i] = *(const bf16x8*)(ap + i0 + 32 * i); b[i] = *(const bf16x8*)(bp + i0 + 32 * i); }
#pragma unroll
            for (int i = 0; i < STEPS; ++i) acc = __builtin_amdgcn_mfma_f32_16x16x32_bf16(a[i], b[i], acc, 0, 0, 0);
        }
#pragma unroll
        for (int j = 0; j < 4; ++j) PS[F.wave * 256 + (kq * 4 + j) * 16 + r] = acc[j];
        __syncthreads();
        if (F.tid < 256) { float v = 0.f;
#pragma unroll
            for (int w = 0; w < 8; ++w) v += PS[w * 256 + F.tid];
            P.out(t, F.tid >> 4, F.tid & 15, v); }
        __syncthreads();
    }
}
struct SkP1 {
    const bf16_t* mixed; const bf16_t* wcat; bf16_t* rkv; bf16_t* l1o;
    __device__ __forceinline__ int n0(int t) const { return t < 768 ? 16 * t : (t < 776 ? 12288 + 16 * (t - 768) : (t < 784 ? 12544 + 16 * (t - 776) : 12800 + 16 * (t - 784))); }
    __device__ __forceinline__ void tile(int t, const bf16_t*& A, int& lda, const bf16_t*& B) const {
        const int gi = t < 768 ? t >> 8 : (t < 776 ? 3 : (t < 784 ? 4 : 5));
        A = mixed + (size_t)gi * RP * D + (size_t)MREAL * D; lda = D; B = wcat + (size_t)n0(t) * D; }
    __device__ __forceinline__ void out(int t, int row, int c, float v) const {
        if (t < 768) rkv[(size_t)(t >> 8) * RP * D + hm_off_meta(row, 16 * (t & 255) + c)] = (bf16_t)(pk2(v, 0.f) & 0xffffu);
        else if (t < 776) l1o[(size_t)(MREAL + row) * 512 + 16 * (t - 768) + c] = (bf16_t)(pk2(1.0f - 2.0f * frcp(fexp(2.0f * v) + 1.0f), 0.f) & 0xffffu);
        else if (t < 784) l1o[(size_t)RP * 512 + (size_t)(MREAL + row) * 512 + 16 * (t - 776) + c] = (bf16_t)(pk2(v, 0.f) & 0xffffu);
        else l1o[(size_t)2 * RP * 512 + (size_t)(MREAL + row) * 512 + 16 * (t - 784) + c] = (bf16_t)(pk2(fsigmoid(v), 0.f) & 0xffffu);
    }
};
struct SkL2 {
    const bf16_t* l1o; const bf16_t* w2; bf16_t* wdec; bf16_t* aa; bf16_t* gg; const float* w0; const float* a0;
    __device__ __forceinline__ void tile(int t, const bf16_t*& A, int& lda, const bf16_t*& B) const { A = l1o + (size_t)(t >> 8) * RP * 512 + (size_t)MREAL * 512; lda = 512; B = w2 + (size_t)16 * t * 512; }
    __device__ __forceinline__ void out(int t, int row, int c, float v) const {
        const int sub = t >> 8, col = 16 * (t & 255) + c; const size_t off = hm_off_meta(row, col);
        if (sub == 0) wdec[off] = (bf16_t)(pk2(1.0f - fexp(-0.60653065971f * fsigmoid(v + w0[col])), 0.f) & 0xffffu);
        else if (sub == 1) aa[off] = (bf16_t)(pk2(fsigmoid(v + a0[col]), 0.f) & 0xffffu);
        else gg[off] = (bf16_t)(pk2(v, 0.f) & 0xffffu);
    }
};
template <bool LNRES> struct SkRes {
    const bf16_t* A_; int lda_; const bf16_t* Bt; int K; float* z; const float* res; const float* st_in; const float* g; const float* b; float* st_out;
    __device__ __forceinline__ void tile(int t, const bf16_t*& A, int& lda, const bf16_t*& B) const { A = A_; lda = lda_; B = Bt + (size_t)16 * t * K; }
    __device__ __forceinline__ void out(int t, int row, int c, float v) const { const int col = 16 * t + c; const size_t off = (size_t)row * D + col;
        float r = res[off];
        if (LNRES) { float rho, nmr; ln_row_stats(st_in, MREAL + row, rho, nmr); r = (r * rho + nmr) * g[col] + b[col]; }
        const float zz = DN_ALPHA * r + v; z[off] = zz;
        const float s1 = red16(zz), s2 = red16(zz * zz);
        if (c == 0) { atomicAdd(st_out + 2 * (MREAL + row), s1); atomicAdd(st_out + 2 * (MREAL + row) + 1, s2); } }
};
struct SkUp {
    const bf16_t* hb; const bf16_t* Bt; bf16_t* u;
    __device__ __forceinline__ void tile(int t, const bf16_t*& A, int& lda, const bf16_t*& B) const { A = hb; lda = D; B = Bt + (size_t)16 * t * D; }
    __device__ __forceinline__ void out(int t, int row, int c, float v) const { const float a = fmaxf(v, 0.f); u[(size_t)row * FF + 16 * t + c] = (bf16_t)(pk2(a * a, 0.f) & 0xffffu); }
};
struct SkKv {
    const bf16_t* hb; const bf16_t* Bt; bf16_t* kb;
    __device__ __forceinline__ void tile(int t, const bf16_t*& A, int& lda, const bf16_t*& B) const { A = hb; lda = D; B = Bt + (size_t)16 * t * D; }
    __device__ __forceinline__ void out(int t, int row, int c, float v) const {
        if (t < 256) kb[(size_t)row * D + 16 * t + c] = (bf16_t)(pk2(v, 0.f) & 0xffffu);
        else (kb - (size_t)MREAL * D + (size_t)RP * D)[(size_t)(16 * (t - 256) + c) * RP + MREAL + row] = (bf16_t)(pk2(v, 0.f) & 0xffffu); }
};

constexpr int SC_RDY = 0;
constexpr int SC_VB = SC_RDY + 32 * 5 * 64 * 4;
constexpr int SC_YR = SC_VB + 32 * 64 * 4;
struct ScanArgs { const bf16_t* r; const bf16_t* k; const bf16_t* v; const bf16_t* v2; const bf16_t* w; const bf16_t* a; const bf16_t* g; bf16_t* yg;
                  const float* k_k; const float* k_a; const float* r_k; const float* gn_g; const float* gn_b; };
constexpr int SC_SIDE = 65536;
__device__ __forceinline__ f32x4 red8x4(f32x4 x) {
    float a = x[0], b = x[1], c = x[2], d = x[3];
#define R8_ROW(mod) "v_add_f32_dpp %0, %0, %0 " mod " row_mask:0xf bank_mask:0xf bound_ctrl:1\n\tv_add_f32_dpp %1, %1, %1 " mod " row_mask:0xf bank_mask:0xf bound_ctrl:1\n\t" \
                    "v_add_f32_dpp %2, %2, %2 " mod " row_mask:0xf bank_mask:0xf bound_ctrl:1\n\tv_add_f32_dpp %3, %3, %3 " mod " row_mask:0xf bank_mask:0xf bound_ctrl:1\n\t"
    asm volatile("s_nop 1\n\t" R8_ROW("quad_perm:[1,0,3,2]") R8_ROW("quad_perm:[2,3,0,1]") R8_ROW("row_half_mirror") : "+v"(a), "+v"(b), "+v"(c), "+v"(d));
#undef R8_ROW
    return (f32x4){a, b, c, d};
}
template <bool SIDE, int NJ> __device__ __forceinline__ void scan_role(const Frame& F, const ScanArgs& A, const TrJob (&J)[NJ]) {
    LAS float* RDY = (LAS float*)(F.lds + SC_RDY); LAS float* VB = (LAS float*)(F.lds + SC_VB); LAS float* YR = (LAS float*)(F.lds + SC_YR);
    const int tid = F.tid, lane = F.lane, w = F.wave;
    const int tt = tid >> 4, j4 = (tid & 15) * 4;
    const int c8 = (lane & 7) * 8, i0 = 16 * (w & 3) + 2 * (lane >> 3);
    LAS unsigned* sscr = (LAS unsigned*)(F.lds + SC_SIDE + (w & 3) * 4608);
    const int side_total = tr_total<NJ>(J), gsw = F.vcu * 4 + (w & 3), NSW = F.G * 4;
    int side_next = gsw;
    TrRef SR0 = tr_lookup<NJ>(J, 0), SR1 = SR0, SR2 = SR0; bool sh0 = false, sh1 = false, sh2 = false;
    f32x4 sv0[8], sv1[8], sv2[8];
    for (int bh = blockIdx.x; bh < NBATCH * RW_H; bh += F.G) {
        const int b = bh >> 6, h = bh & 63, col = h * 64 + j4;
        const f32x4 ckk = *(const f32x4*)(A.k_k + col), cka = *(const f32x4*)(A.k_a + col), crk = *(const f32x4*)(A.r_k + col);
        const f32x4 cgg = *(const f32x4*)(A.gn_g + col), cgb = *(const f32x4*)(A.gn_b + col);
        f32x2 S0[4], S1[4];
#pragma unroll
        for (int q = 0; q < 4; ++q) { S0[q] = (f32x2){0.f, 0.f}; S1[q] = (f32x2){0.f, 0.f}; }
        u32x2 qr, qk, qv, qw, qa, qv2 = (u32x2){0u, 0u};
        {
            const size_t off = hm_off_meta(tt & 15, col);
            qr = *(const u32x2*)(A.r + off); qk = *(const u32x2*)(A.k + off); qv = *(const u32x2*)(A.v + off); qw = *(const u32x2*)(A.w + off); qa = *(const u32x2*)(A.a + off);
        }
        u32x2 pend_wv = (u32x2){0u, 0u}; bf16_t* pend_ptr = nullptr;
        for (int c = 0; c <= 64; ++c) {
            const int nsteps = c == 0 ? NMETA : 32;
            const int rowbase = c == 0 ? MREAL : b * TSEQ + (c - 1) * 32;
            const bool act = tt < nsteps;
            const f32x4 pr = {bf_lo(qr.x), bf_hi(qr.x), bf_lo(qr.y), bf_hi(qr.y)}, pk = {bf_lo(qk.x), bf_hi(qk.x), bf_lo(qk.y), bf_hi(qk.y)}, pv = {bf_lo(qv.x) + bf_lo(qv2.x), bf_hi(qv.x) + bf_hi(qv2.x), bf_lo(qv.y) + bf_lo(qv2.y), bf_hi(qv.y) + bf_hi(qv2.y)};
            const f32x4 pw = {1.0f - bf_lo(qw.x), 1.0f - bf_hi(qw.x), 1.0f - bf_lo(qw.y), 1.0f - bf_hi(qw.y)}, pa = {bf_lo(qa.x), bf_hi(qa.x), bf_lo(qa.y), bf_hi(qa.y)};
            const f32x4 kx = pk * ckk;
            const float ss = red16((kx[0] * kx[0] + kx[1] * kx[1]) + (kx[2] * kx[2] + kx[3] * kx[3]));
            const float inv = 1.0f / fmaxf(sqrtf(ss), 1e-12f);
            const f32x4 kk = kx * inv;
            const f32x4 kp = pk * ((pa - 1.0f) * cka + 1.0f);
            const f32x4 bb = -(kk * pa);
            const f32x4 wr4 = pw * pr;
            const float br = red16((bb[0] * pr[0] + bb[1] * pr[1]) + (bb[2] * pr[2] + bb[3] * pr[3]));
            const float kr = red16((kp[0] * pr[0] + kp[1] * pr[1]) + (kp[2] * pr[2] + kp[3] * pr[3]));
            const f32x4 rkk = pr * kp * crk;
            const float bonus = red16((rkk[0] + rkk[1]) + (rkk[2] + rkk[3]));
            const f32x4 vkeep = pv;
            if (act) {
                LAS float* rd = RDY + tt * 320 + j4;
                *(LAS f32x4*)(rd) = kk; *(LAS f32x4*)(rd + 64) = wr4; *(LAS f32x4*)(rd + 128) = pw; *(LAS f32x4*)(rd + 192) = bb; *(LAS f32x4*)(rd + 256) = kp;
                *(LAS f32x4*)(VB + tt * 64 + j4) = pv;
            }
            asm volatile("" : "+v"(qr), "+v"(qk), "+v"(qv), "+v"(qw), "+v"(qa), "+v"(qv2));
            if (pend_ptr) { *(u32x2*)pend_ptr = pend_wv; pend_ptr = nullptr; }
            u32x2 pg = (u32x2){0u, 0u};
            if (act) pg = *(const u32x2*)(A.g + (c == 0 ? hm_off_meta(tt, col) : hm_off(rowbase + tt, col)));
            if (c < 64) { const size_t off = hm_off(b * TSEQ + c * 32 + tt, col);
                qr = *(const u32x2*)(A.r + off); qk = *(const u32x2*)(A.k + off); qv = *(const u32x2*)(A.v + off); qw = *(const u32x2*)(A.w + off); qa = *(const u32x2*)(A.a + off);
                if (h >= 48) qv2 = *(const u32x2*)(A.v2 + off); }
            __syncthreads();
            if constexpr (!SIDE) {
                const LAS float* rd = RDY + c8;
                f32x4 kkA = *(const LAS f32x4*)(rd), kkB = *(const LAS f32x4*)(rd + 4), wrA = *(const LAS f32x4*)(rd + 64), wrB = *(const LAS f32x4*)(rd + 68), wA = *(const LAS f32x4*)(rd + 128), wB = *(const LAS f32x4*)(rd + 132);
                f32x4 bA = *(const LAS f32x4*)(rd + 192), bB = *(const LAS f32x4*)(rd + 196), kpA = *(const LAS f32x4*)(rd + 256), kpB = *(const LAS f32x4*)(rd + 260);
                f32x2 v2 = *(const LAS f32x2*)(VB + i0);
#pragma unroll 2
                for (int s = 0; s < nsteps; ++s) {
                    const int sn = (s + 1 < nsteps) ? s + 1 : s;
                    const LAS float* rn = RDY + sn * 320 + c8;
                    const f32x4 nkkA = *(const LAS f32x4*)(rn), nkkB = *(const LAS f32x4*)(rn + 4), nwrA = *(const LAS f32x4*)(rn + 64), nwrB = *(const LAS f32x4*)(rn + 68), nwA = *(const LAS f32x4*)(rn + 128), nwB = *(const LAS f32x4*)(rn + 132);
                    const f32x4 nbA = *(const LAS f32x4*)(rn + 192), nbB = *(const LAS f32x4*)(rn + 196), nkpA = *(const LAS f32x4*)(rn + 256), nkpB = *(const LAS f32x4*)(rn + 260);
                    const f32x2 nv = *(const LAS f32x2*)(VB + sn * 64 + i0);
                    const f32x2 kkv[4] = {{kkA[0], kkA[1]}, {kkA[2], kkA[3]}, {kkB[0], kkB[1]}, {kkB[2], kkB[3]}}, wrv[4] = {{wrA[0], wrA[1]}, {wrA[2], wrA[3]}, {wrB[0], wrB[1]}, {wrB[2], wrB[3]}};
                    const f32x2 wv[4] = {{wA[0], wA[1]}, {wA[2], wA[3]}, {wB[0], wB[1]}, {wB[2], wB[3]}}, bv[4] = {{bA[0], bA[1]}, {bA[2], bA[3]}, {bB[0], bB[1]}, {bB[2], bB[3]}};
                    const f32x2 kpv[4] = {{kpA[0], kpA[1]}, {kpA[2], kpA[3]}, {kpB[0], kpB[1]}, {kpB[2], kpB[3]}};
                    f32x2 d0 = S0[0] * kkv[0], d1 = S1[0] * kkv[0], d2 = S0[0] * wrv[0], d3 = S1[0] * wrv[0];
#pragma unroll
                    for (int q = 1; q < 4; ++q) { d0 = pfma2(S0[q], kkv[q], d0); d1 = pfma2(S1[q], kkv[q], d1); d2 = pfma2(S0[q], wrv[q], d2); d3 = pfma2(S1[q], wrv[q], d3); }
                    f32x4 dd; dd[0] = d0[0] + d0[1]; dd[1] = d1[0] + d1[1]; dd[2] = d2[0] + d2[1]; dd[3] = d3[0] + d3[1];
                    const f32x2 v0 = {v2[0], v2[0]}, v1 = {v2[1], v2[1]};
                    f32x2 T0[4], T1[4];
#pragma unroll
                    for (int q = 0; q < 4; ++q) { T0[q] = pfma2(S0[q], wv[q], v0 * kpv[q]); T1[q] = pfma2(S1[q], wv[q], v1 * kpv[q]); }
                    dd = red8x4(dd);
                    const f32x2 p0 = {dd[0], dd[0]}, p1 = {dd[1], dd[1]};
#pragma unroll
                    for (int q = 0; q < 4; ++q) { S0[q] = pfma2(p0, bv[q], T0[q]); S1[q] = pfma2(p1, bv[q], T1[q]); }
                    if ((lane & 7) == 0) *(LAS f32x4*)(YR + s * 128 + i0 * 2) = dd;
                    kkA = nkkA; kkB = nkkB; wrA = nwrA; wrB = nwrB; wA = nwA; wB = nwB; bA = nbA; bB = nbB; kpA = nkpA; kpB = nkpB; v2 = nv;
                }
            } else {
                if (sh0) tr_store(SR0, lane, sv0, sscr);
                if (sh1) tr_store(SR1, lane, sv1, sscr);
                if (sh2) tr_store(SR2, lane, sv2, sscr);
                sh0 = side_next < side_total; if (sh0) { SR0 = tr_lookup<NJ>(J, side_next); tr_load(SR0, lane, sv0); side_next += NSW; }
                sh1 = side_next < side_total; if (sh1) { SR1 = tr_lookup<NJ>(J, side_next); tr_load(SR1, lane, sv1); side_next += NSW; }
                sh2 = side_next < side_total; if (sh2) { SR2 = tr_lookup<NJ>(J, side_next); tr_load(SR2, lane, sv2); side_next += NSW; }
            }
            __syncthreads();
            if (act && (c > 0 || b == 0)) {
                const f32x4 ya = *(const LAS f32x4*)(YR + tt * 128 + j4 * 2), yb = *(const LAS f32x4*)(YR + tt * 128 + j4 * 2 + 4);
                f32x4 y4;
                y4[0] = ya[2] + ya[0] * br + vkeep[0] * kr; y4[1] = ya[3] + ya[1] * br + vkeep[1] * kr;
                y4[2] = yb[2] + yb[0] * br + vkeep[2] * kr; y4[3] = yb[3] + yb[1] * br + vkeep[3] * kr;
                const float mu = red16((y4[0] + y4[1]) + (y4[2] + y4[3])) * (1.0f / 64.0f);
                const f32x4 d = y4 - mu;
                const float var = red16((d[0] * d[0] + d[1] * d[1]) + (d[2] * d[2] + d[3] * d[3])) * (1.0f / 64.0f);
                const float rstd = 1.0f / sqrtf(var + GN_EPS);
                f32x4 o = d * rstd * cgg + cgb + vkeep * bonus;
                o[0] *= bf_lo(pg.x); o[1] *= bf_hi(pg.x); o[2] *= bf_lo(pg.y); o[3] *= bf_hi(pg.y);
                u32x2 wv; wv.x = pk2(o[0], o[1]); wv.y = pk2(o[2], o[3]);
                pend_wv = wv; pend_ptr = A.yg + (size_t)(rowbase + tt) * D + col;
            }
        }
        if (pend_ptr) { *(u32x2*)pend_ptr = pend_wv; pend_ptr = nullptr; }
        __syncthreads();
    }
    if constexpr (SIDE) {
        if (sh0) tr_store(SR0, lane, sv0, sscr);
        if (sh1) tr_store(SR1, lane, sv1, sscr);
        if (sh2) tr_store(SR2, lane, sv2, sscr);
        for (int it = side_next; it < side_total; it += NSW) {
            const TrRef R = tr_lookup<NJ>(J, it); f32x4 v[8]; tr_load(R, lane, v); tr_store(R, lane, v, sscr); }
    }
}
template <int NJ> __device__ __forceinline__ void scan_phase(const Frame& F, const ScanArgs& A, const TrJob (&J)[NJ]) {
    if (F.wave < 4) scan_role<false, NJ>(F, A, J); else scan_role<true, NJ>(F, A, J);
}

constexpr int AT_KT = 0;
constexpr int AT_VT = 32768;
constexpr int AT_QS = 65536;
#define MFMA32(a, b, c) __builtin_amdgcn_mfma_f32_32x32x16_bf16((a), (b), (c), 0, 0, 0)
typedef _Float16 f16x8 __attribute__((ext_vector_type(8)));
typedef _Float16 f16x2 __attribute__((ext_vector_type(2)));
__device__ __forceinline__ unsigned pkh2(float lo, float hi) { f32x2 v = {lo, hi}; return __builtin_bit_cast(unsigned, __builtin_convertvector(v, f16x2)); }
__device__ __forceinline__ void attn_phase(const Frame& F, const bf16_t* qb, const bf16_t* kb, const bf16_t* vt, bf16_t* ob) {
    const int lane = F.lane, w = F.wave, c = lane & 31, h = lane >> 5;
    LAS unsigned char* KT = F.lds + AT_KT; LAS unsigned char* VT = F.lds + AT_VT;
    f16x8 U[2];
#pragma unroll
    for (int s = 0; s < 2; ++s)
#pragma unroll
        for (int j = 0; j < 8; ++j) { const int kin = 16 * s + 8 * (j >> 2) + 4 * h + (j & 3); U[s][j] = kin >= c ? (_Float16)-1.0f : (_Float16)0.0f; }
    const int dk_key = 4 * w + (lane >> 4), dk_ch = (lane & 15) ^ (dk_key & 15);
    const int dv_d = 16 * w + (lane >> 2), dv_ch = (lane & 3) ^ ((dv_d >> 2) & 3);
    for (int unit = blockIdx.x; unit < NBATCH * SB_H * 4; unit += F.G) {
        const int bh = unit >> 2, pr = unit & 3, b = bh >> 5, hh = bh & 31;
        const bf16_t* kcol = kb + hh * SB_D + dk_ch * 8;
        const bf16_t* vrow = vt + (size_t)(hh * SB_D + dv_d) * RP + dv_ch * 8;
        for (int half = 0; half < 2; ++half) {
            const int Q0 = (half == 0 ? 7 - pr : pr) * 256, q0 = Q0 + 32 * w, diag = q0 >> 5;
            const size_t qrow = (size_t)b * TSEQ + q0 + c;
            LAS unsigned char* QS = F.lds + AT_QS + w * 8192 + c * 256;
#pragma unroll
            for (int ks = 0; ks < 8; ++ks) *(LAS bf16x8*)(QS + (((2 * ks + h) ^ (c & 15)) * 16)) = *(const bf16x8*)(qb + qrow * D + hh * SB_D + 16 * ks + 8 * h);
            f32x16 O[4];
#pragma unroll
            for (int dt = 0; dt < 4; ++dt)
#pragma unroll
                for (int i = 0; i < 16; ++i) O[dt][i] = 0.f;
            float carry = 0.f;
            const int stmax = (Q0 >> 5) + 7, nstg = stmax + 2;
#define AT_DMA(n_) do { const int n__ = (n_); const int slot = n__ & 3; const bool mt = (n__ == nstg - 1); \
                const size_t tok = mt ? (size_t)MREAL : (size_t)b * TSEQ + 32 * (stmax - n__); \
                const bf16_t* ksrc = kcol + (tok + (mt ? (dk_key & 15) : dk_key)) * D; \
                const bf16_t* vsrc = mt ? (vrow - dv_ch * 8 + (dv_ch & 1) * 8 + tok) : (vrow + tok); \
                __builtin_amdgcn_global_load_lds((const unsigned*)ksrc, (LAS unsigned*)(KT + slot * 8192 + w * 1024), 16, 0, 0); \
                __builtin_amdgcn_global_load_lds((const unsigned*)vsrc, (LAS unsigned*)(VT + slot * 8192 + w * 1024), 16, 0, 0); } while (0)
            AT_DMA(0); AT_DMA(1); AT_DMA(2);
            for (int n = 0; n < nstg; ++n) {
                const int rem = nstg - 1 - n;
                if (rem >= 2) asm volatile("s_waitcnt vmcnt(4)" ::: "memory"); else if (rem == 1) asm volatile("s_waitcnt vmcnt(2)" ::: "memory"); else asm volatile("s_waitcnt vmcnt(0)" ::: "memory");
                __builtin_amdgcn_s_barrier();
                asm volatile("" ::: "memory");
                if (n + 3 < nstg) AT_DMA(n + 3);
                const LAS unsigned char* KTb = KT + (n & 3) * 8192; const LAS unsigned char* VTb = VT + (n & 3) * 8192;
                const bool meta = (n == nstg - 1);
                const int st_abs = stmax - n;
                if (meta || st_abs <= diag) {
                    const int limit = meta ? NMETA : ((st_abs == diag) ? c : 64);
                    f32x16 Z;
#pragma unroll
                    for (int i = 0; i < 16; ++i) Z[i] = 0.f;
#pragma unroll
                    for (int ks = 0; ks < 8; ++ks) { const bf16x8 a = *(const LAS bf16x8*)(KTb + c * 256 + (((2 * ks + h) ^ (c & 15)) * 16)); const bf16x8 qf = *(const LAS bf16x8*)(QS + (((2 * ks + h) ^ (c & 15)) * 16)); Z = MFMA32(a, qf, Z); }
                    f32x16 X, Y;
#pragma unroll
                    for (int i = 0; i < 16; ++i) X[i] = flog2(1.0f + fexp2(fminf(Z[i], 100.f)));
                    if (limit < 64) {
#pragma unroll
                        for (int i = 0; i < 16; ++i) { const int row = (i & 3) + 8 * (i >> 2) + 4 * h; X[i] = row < limit ? X[i] : 0.f; }
                    }
#pragma unroll
                    for (int i = 0; i < 16; ++i) Y[i] = Z[i] + carry;
                    f16x8 Xh[2];
#pragma unroll
                    for (int s = 0; s < 2; ++s) { u32x4 hu;
#pragma unroll
                        for (int jj = 0; jj < 4; ++jj) hu[jj] = pkh2(X[8 * s + 2 * jj], X[8 * s + 2 * jj + 1]);
                        Xh[s] = __builtin_bit_cast(f16x8, hu); }
                    Y = __builtin_amdgcn_mfma_f32_32x32x16_f16(U[0], Xh[0], Y, 0, 0, 0); Y = __builtin_amdgcn_mfma_f32_32x32x16_f16(U[1], Xh[1], Y, 0, 0, 0);
                    carry = __shfl(Y[0] - Z[0], c);
#pragma unroll
                    for (int i = 0; i < 16; ++i) Y[i] = fexp2(Y[i]);
                    if (limit < 64) {
#pragma unroll
                        for (int i = 0; i < 16; ++i) { const int row = (i & 3) + 8 * (i >> 2) + 4 * h; Y[i] = row < limit ? Y[i] : 0.f; }
                    }
                    bf16x8 Pb[2];
#pragma unroll
                    for (int s = 0; s < 2; ++s) { u32x4 pu;
#pragma unroll
                        for (int jj = 0; jj < 4; ++jj) pu[jj] = pk2(Y[8 * s + 2 * jj], Y[8 * s + 2 * jj + 1]);
                        Pb[s] = __builtin_bit_cast(bf16x8, pu); }
#pragma unroll
                    for (int dt = 0; dt < 4; ++dt) { const int d = 32 * dt + c; const LAS unsigned char* rowp = VTb + d * 64 + 8 * h; const int sw = (d >> 2) & 3;
#pragma unroll
                        for (int s = 0; s < 2; ++s) {
                            const u32x2 lo = *(const LAS u32x2*)(rowp + (((2 * s) ^ sw) * 16)), hi = *(const LAS u32x2*)(rowp + (((2 * s + 1) ^ sw) * 16));
                            const u32x4 av = (u32x4){lo.x, lo.y, hi.x, hi.y};
                            O[dt] = MFMA32(__builtin_bit_cast(bf16x8, av), Pb[s], O[dt]); } }
                }
            }
#undef AT_DMA
#pragma unroll
            for (int dt = 0; dt < 4; ++dt)
#pragma unroll
                for (int g = 0; g < 4; ++g) { u32x2 wv; wv.x = pk2(O[dt][4 * g], O[dt][4 * g + 1]); wv.y = pk2(O[dt][4 * g + 2], O[dt][4 * g + 3]);
                    *(u32x2*)(ob + qrow * D + hh * SB_D + 32 * dt + 8 * g + 4 * h) = wv; }
            __syncthreads();
        }
    }
}

constexpr int N_PHASES = 16;
#ifndef MK_ONE_LAUNCH
#define MK_ONE_LAUNCH 1
#endif
#ifndef MK_PROBE_SK
#define MK_PROBE_SK 0
#endif
#ifndef MK_PROBE_MASK
#define MK_PROBE_MASK 0u
#endif
struct KArgs { const float* in[26]; float* out; unsigned char* ws; int ph_lo, ph_hi, li, pad; };

template <int PH> __device__ __forceinline__ void run_phase(const Frame& F, const KArgs& args) {
    unsigned char* ws = args.ws;
    const float* x = args.in[I_X]; const float* meta = args.in[I_META];
    LAS unsigned char* ring = F.lds;
    const int bid = (int)blockIdx.x;
    float* const ZA = (float*)(ws + WS_ZB); float* const ZB2 = (float*)(ws + WS_HF);
    float* const ST1 = (float*)(ws + WS_CTL + CTL_STATS), * const ST2 = ST1 + 2 * RP, * const ST3 = ST2 + 2 * RP, * const ST4 = ST3 + 2 * RP;
    const float* const g_m0 = args.in[I_LNMG]; const float* const b_m0 = args.in[I_LNMB]; const float* const g_f0 = args.in[I_LNFG]; const float* const b_f0 = args.in[I_LNFB];
    const float* const g_m1 = g_m0 + D; const float* const b_m1 = b_m0 + D; const float* const g_f1 = g_f0 + D; const float* const b_f1 = b_f0 + D;
    if constexpr (PH == 0) {
        zero_bytes(F, ws + WS_L1O, L1O_BYTES);
        const TrJob J[9] = {
            {args.in[I_WRKV], D, D, D, D, (bf16_t*)(ws + W0_CAT)},
            {args.in[I_WRKV] + (size_t)D * D, D, D, D, D, (bf16_t*)(ws + W0_CAT) + (size_t)4096 * D},
            {args.in[I_WRKV] + (size_t)2 * D * D, D, D, D, D, (bf16_t*)(ws + W0_CAT) + (size_t)8192 * D},
            {args.in[I_W1], D, 128, D, 256, (bf16_t*)(ws + W0_CAT) + (size_t)12288 * D},
            {args.in[I_A1], D, 128, D, 256, (bf16_t*)(ws + W0_CAT) + (size_t)12544 * D},
            {args.in[I_G1], D, 480, D, 512, (bf16_t*)(ws + W0_CAT) + (size_t)12800 * D},
            {args.in[I_W2], 128, D, 512, D, (bf16_t*)(ws + W0_L2)},
            {args.in[I_A2], 128, D, 512, D, (bf16_t*)(ws + W0_L2) + (size_t)4096 * 512},
            {args.in[I_G2], 480, D, 512, D, (bf16_t*)(ws + W0_L2) + (size_t)8192 * 512}};
        tr_jobs<9>(F, J);
        mix_phase(F, x, meta, args.in[I_MU], (bf16_t*)(ws + WS_X));
    } else if constexpr (PH == 1) {
        { SkP1 Q{(const bf16_t*)(ws + WS_X), (const bf16_t*)(ws + W0_CAT), (bf16_t*)(ws + WS_Y), (bf16_t*)(ws + WS_L1O)}; skinny_gemm<16>(F, D, 814, Q); if (MK_PROBE_SK) skinny_gemm<16>(F, D, 814, Q); }
        ProbP1 P; P.K = D; P.S.init(32, 48, F.G, bid, 8); P.mixed = (const char*)(ws + WS_X); P.wcat = (const char*)(ws + W0_CAT);
        EpiP1 E{(bf16_t*)(ws + WS_Y), (bf16_t*)(ws + WS_L1O)};
        pg8::gemm_phase<ProbP1, EpiP1, true, true>(ring, P, E);
    } else if constexpr (PH == 2) {
        { SkL2 Q{(const bf16_t*)(ws + WS_L1O), (const bf16_t*)(ws + W0_L2), (bf16_t*)(ws + WS_WDEC), (bf16_t*)(ws + WS_AA), (bf16_t*)(ws + WS_GG), args.in[I_W0], args.in[I_A0]}; skinny_gemm<2>(F, 512, 768, Q); if (MK_PROBE_SK) skinny_gemm<2>(F, 512, 768, Q); }
        ProbL2 P; P.K = 512; P.S.init(32, 48, F.G, bid); P.l1o = (const char*)(ws + WS_L1O); P.w2 = (const char*)(ws + W0_L2);
        EpiL2 E{(bf16_t*)(ws + WS_WDEC), (bf16_t*)(ws + WS_AA), (bf16_t*)(ws + WS_GG), args.in[I_W0], args.in[I_A0]};
        pg8::gemm_phase<ProbL2, EpiL2, true, true>(ring, P, E);
    } else if constexpr (PH == 3) {
        ScanArgs A{(const bf16_t*)(ws + WS_Y), (const bf16_t*)(ws + WS_Y) + (size_t)RP * D, (const bf16_t*)(ws + WS_Y) + (size_t)2 * RP * D, (const bf16_t*)(ws + WS_Y) + (size_t)3 * RP * D, (const bf16_t*)(ws + WS_WDEC), (const bf16_t*)(ws + WS_AA),
                   (const bf16_t*)(ws + WS_GG), (bf16_t*)(ws + WS_YG), args.in[I_KK], args.in[I_KA], args.in[I_RK], args.in[I_GNG], args.in[I_GNB]};
        const TrJob J[7] = {
            {args.in[I_RWO], D, D, D, D, (bf16_t*)(ws + W0_O)},
            {args.in[I_WUP], D, FF, D, FF, (bf16_t*)(ws + W0_UP)},
            {args.in[I_WDN], FF, D, FF, D, (bf16_t*)(ws + W0_DN)},
            {args.in[I_SBQKV], D, 3 * D, D, 3 * D, (bf16_t*)(ws + W1_QKV)},
            {args.in[I_SBO], D, D, D, D, (bf16_t*)(ws + W1_O)},
            {args.in[I_WUP] + (size_t)D * FF, D, FF, D, FF, (bf16_t*)(ws + W1_UP)},
            {args.in[I_WDN] + (size_t)D * FF, FF, D, FF, D, (bf16_t*)(ws + W1_DN)}};
        scan_phase(F, A, J);
    } else if constexpr (PH == 4) {
        { SkRes<false> Q{(const bf16_t*)(ws + WS_YG) + (size_t)MREAL * D, D, (const bf16_t*)(ws + W0_O), D, ZA + (size_t)MREAL * D, meta, nullptr, nullptr, nullptr, ST1}; skinny_gemm<16>(F, D, 256, Q); }
        ProbG P; P.K = D; P.S.init(32, 16, F.G, bid); P.A = (const char*)(ws + WS_YG); P.Bt = (const char*)(ws + W0_O);
        EpiRes<false> E{ZA, x, nullptr, nullptr, nullptr, ST1};
        pg8::gemm_phase<ProbG, EpiRes<false>, true, true>(ring, P, E);
    } else if constexpr (PH == 5) {
        ln_apply(F, ZA, ST1, g_m0, b_m0, (bf16_t*)(ws + WS_HB), nullptr, MROWS);
    } else if constexpr (PH == 6) {
        { SkUp Q{(const bf16_t*)(ws + WS_HB) + (size_t)MREAL * D, (const bf16_t*)(ws + W0_UP), (bf16_t*)(ws + WS_U0) + (size_t)MREAL * FF}; skinny_gemm<16>(F, D, 1024, Q); if (MK_PROBE_SK) skinny_gemm<16>(F, D, 1024, Q); }
        ProbG P; P.K = D; P.S.init(32, 64, F.G, bid); P.A = (const char*)(ws + WS_HB); P.Bt = (const char*)(ws + W0_UP);
        EpiUp E{(bf16_t*)(ws + WS_U0)};
        pg8::gemm_phase<ProbG, EpiUp, true, true>(ring, P, E);
    } else if constexpr (PH == 7) {
        { SkRes<true> Q{(const bf16_t*)(ws + WS_U0) + (size_t)MREAL * FF, FF, (const bf16_t*)(ws + W0_DN), FF, ZB2 + (size_t)MREAL * D, ZA + (size_t)MREAL * D, ST1, g_m0, b_m0, ST2}; skinny_gemm<16>(F, FF, 256, Q); }
        ProbG P; P.K = FF; P.S.init(32, 16, F.G, bid); P.A = (const char*)(ws + WS_U0); P.Bt = (const char*)(ws + W0_DN);
        EpiRes<true> E{ZB2, ZA, ST1, g_m0, b_m0, ST2};
        pg8::gemm_phase<ProbG, EpiRes<true>, true, true>(ring, P, E);
    } else if constexpr (PH == 8) {
        ln_apply(F, ZB2, ST2, g_f0, b_f0, (bf16_t*)(ws + WS_HB), nullptr, MROWS);
    } else if constexpr (PH == 9) {
        { SkKv Q{(const bf16_t*)(ws + WS_HB) + (size_t)MREAL * D, (const bf16_t*)(ws + W1_QKV) + (size_t)D * D, (bf16_t*)(ws + WS_KB) + (size_t)MREAL * D}; skinny_gemm<16>(F, D, 512, Q); if (MK_PROBE_SK) skinny_gemm<16>(F, D, 512, Q); }
        ProbQkv P; P.K = D; P.S.init(32, 48, F.G, bid); P.hb = (const char*)(ws + WS_HB); P.w = (const char*)(ws + W1_QKV);
        EpiQkv E{(bf16_t*)(ws + WS_QB)};
        pg8::gemm_phase<ProbQkv, EpiQkv, true, true>(ring, P, E);
    } else if constexpr (PH == 10) {
        attn_phase(F, (const bf16_t*)(ws + WS_QB), (const bf16_t*)(ws + WS_KB), (const bf16_t*)(ws + WS_VB), (bf16_t*)(ws + WS_OB));
    } else if constexpr (PH == 11) {
        ProbG P; P.K = D; P.S.init(32, 16, F.G, bid); P.A = (const char*)(ws + WS_OB); P.Bt = (const char*)(ws + W1_O);
        EpiRes<true> E{ZA, ZB2, ST2, g_f0, b_f0, ST3};
        pg8::gemm_phase<ProbG, EpiRes<true>, true, true>(ring, P, E);
    } else if constexpr (PH == 12) {
        ln_apply(F, ZA, ST3, g_m1, b_m1, (bf16_t*)(ws + WS_HB), nullptr, MREAL);
    } else if constexpr (PH == 13) {
        ProbG P; P.K = D; P.S.init(32, 64, F.G, bid); P.A = (const char*)(ws + WS_HB); P.Bt = (const char*)(ws + W1_UP);
        EpiUp E{(bf16_t*)(ws + WS_U1)};
        pg8::gemm_phase<ProbG, EpiUp, true, true>(ring, P, E);
    } else if constexpr (PH == 14) {
        ProbG P; P.K = FF; P.S.init(32, 16, F.G, bid); P.A = (const char*)(ws + WS_U1); P.Bt = (const char*)(ws + W1_DN);
        EpiRes<true> E{ZB2, ZA, ST3, g_m1, b_m1, ST4};
        pg8::gemm_phase<ProbG, EpiRes<true>, true, true>(ring, P, E);
    } else if constexpr (PH == 15) {
        ln_apply(F, ZB2, ST4, g_f1, b_f1, nullptr, args.out, MREAL);
    }
}

__global__ void __launch_bounds__(NWAVES * 64, 2) fwd_kernel(KArgs args) {
    extern __shared__ __attribute__((aligned(16))) unsigned char lds_raw[];
    Frame F;
    F.lds = (LAS unsigned char*)lds_raw;
    F.tid = threadIdx.x; F.lane = F.tid & 63; F.wave = __builtin_amdgcn_readfirstlane(F.tid >> 6);
    F.G = gridDim.x; { const int bx = blockIdx.x; F.vcu = (F.G % 8 == 0) ? (bx % 8) * (F.G / 8) + bx / 8 : bx; }
    volatile LAS unsigned* MISC = (volatile LAS unsigned*)(F.lds + MISC_OFF);
    for (int u = F.tid; u < (LDS_BYTES - LDSCTL_OFF) / 4; u += NWAVES * 64) ((LAS unsigned*)(F.lds + LDSCTL_OFF))[u] = 0u;
    __syncthreads();
    unsigned* ctl = (unsigned*)(args.ws + WS_CTL);
    const int lo = args.ph_lo, hi = args.ph_hi;
    XcdBarrier bar; bar.bar = ctl + CW_BAR + args.li * XCD_BAR_WORDS; bar.x = 0; bar.st = nullptr;
    if (hi - lo > 1 || MK_PROBE_MASK != 0u) bar = xcd_barrier_post(ctl + CW_BAR + args.li * XCD_BAR_WORDS, MISC + 8);
#ifndef ONLY_PHASE
#define ONLY_PHASE -1
#endif
#define IN(k) ((ONLY_PHASE < 0 || ONLY_PHASE == (k)) && lo <= (k) && (k) < hi)
#define PHASE(k) do { if (IN(k)) { run_phase<k>(F, args); if constexpr (((MK_PROBE_MASK) >> (k)) & 1u) { xcd_barrier(bar); run_phase<k>(F, args); } } \
                      if (IN(k) && IN((k) + 1)) xcd_barrier(bar); } while (0)
    PHASE(0); PHASE(1); PHASE(2); PHASE(3); PHASE(4); PHASE(5); PHASE(6); PHASE(7);
    PHASE(8); PHASE(9); PHASE(10); PHASE(11); PHASE(12); PHASE(13); PHASE(14); PHASE(15);
#undef IN
#undef PHASE
}

extern "C" void kernel_launch(void* const* d_in, const int* in_sizes, int n_in, void* d_out, int out_size, void* d_ws, size_t ws_size, hipStream_t stream) {
    static int grid = 0;
    if (grid == 0) {
        if (n_in != 26 || in_sizes[0] != MREAL * D || out_size != MREAL * D || ws_size < WS_END) {
            fprintf(stderr, "kernel_launch: unexpected shapes (n_in %d, in0 %d, out %d, ws %zu, need %zu); nothing launched\n", n_in, n_in > 0 ? in_sizes[0] : -1, out_size, ws_size, (size_t)WS_END); grid = -1; return; }
        int dev = 0, cus = 0, per_cu = 0;
        if (hipGetDevice(&dev) != hipSuccess || hipDeviceGetAttribute(&cus, hipDeviceAttributeMultiprocessorCount, dev) != hipSuccess) { grid = -1; return; }
        if (hipFuncSetAttribute((const void*)fwd_kernel, hipFuncAttributeMaxDynamicSharedMemorySize, LDS_BYTES) != hipSuccess) { fprintf(stderr, "kernel_launch: hipFuncSetAttribute failed\n"); grid = -1; return; }
        if (hipOccupancyMaxActiveBlocksPerMultiprocessor(&per_cu, (const void*)fwd_kernel, NWAVES * 64, LDS_BYTES) != hipSuccess || per_cu < 1)
            fprintf(stderr, "kernel_launch: note: occupancy query reports %d workgroups per CU\n", per_cu);
        (void)hipGetLastError();
        grid = cus;
    }
    if (grid < 0) return;
    if (hipMemsetAsync((char*)d_ws + WS_CTL, 0, CTL_ZERO_BYTES, stream) != hipSuccess) return;
    KArgs a{};
    for (int i = 0; i < 26; ++i) a.in[i] = (const float*)d_in[i];
    a.out = (float*)d_out; a.ws = (unsigned char*)d_ws; a.pad = 0;
#if MK_ONE_LAUNCH
    a.ph_lo = 0; a.ph_hi = N_PHASES; a.li = 0;
    hipLaunchKernelGGL(fwd_kernel, dim3(grid), dim3(NWAVES * 64), LDS_BYTES, stream, a);
#else
    for (int p = 0; p < N_PHASES; ++p) { a.ph_lo = p; a.ph_hi = p + 1; a.li = p;
        hipLaunchKernelGGL(fwd_kernel, dim3(grid), dim3(NWAVES * 64), LDS_BYTES, stream, a); }
#endif
}
```

```cpp
#include <hip/hip_runtime.h>
#include <cstdio>
#include <cstdint>

#define LAS __attribute__((address_space(3)))
#define GAS __attribute__((address_space(1)))
typedef unsigned short bf16_t;
typedef short bf16x8 __attribute__((ext_vector_type(8)));
typedef float f32x2 __attribute__((ext_vector_type(2)));
typedef float f32x4 __attribute__((ext_vector_type(4)));
typedef float f32x16 __attribute__((ext_vector_type(16)));
typedef unsigned u32x2 __attribute__((ext_vector_type(2)));
typedef unsigned u32x4 __attribute__((ext_vector_type(4)));
typedef __bf16 bf16v2 __attribute__((ext_vector_type(2)));

__device__ __forceinline__ unsigned pk2(float lo, float hi) { f32x2 v = {lo, hi}; return __builtin_bit_cast(unsigned, __builtin_convertvector(v, bf16v2)); }
__device__ __forceinline__ float bf_lo(unsigned u) { return __builtin_bit_cast(float, u << 16); }
__device__ __forceinline__ float bf_hi(unsigned u) { return __builtin_bit_cast(float, u & 0xffff0000u); }
__device__ __forceinline__ float fexp2(float x) { return __builtin_amdgcn_exp2f(x); }
__device__ __forceinline__ float flog2(float x) { return __builtin_amdgcn_logf(x); }
__device__ __forceinline__ float fexp(float x) { return __builtin_amdgcn_exp2f(x * 1.44269504089f); }
__device__ __forceinline__ float frcp(float x) { return __builtin_amdgcn_rcpf(x); }
__device__ __forceinline__ float fsigmoid(float x) { return frcp(1.0f + fexp(-x)); }
__device__ __forceinline__ float afma(float a, float b, float c) { float d; asm("v_fma_f32 %0, %1, %2, %3" : "=v"(d) : "v"(a), "v"(b), "v"(c)); return d; }
__device__ __forceinline__ float amul(float a, float b) { float d; asm("v_mul_f32 %0, %1, %2" : "=v"(d) : "v"(a), "v"(b)); return d; }
__device__ __forceinline__ float aadd(float a, float b) { float d; asm("v_add_f32 %0, %1, %2" : "=v"(d) : "v"(a), "v"(b)); return d; }
__device__ __forceinline__ f32x2 pfma2(f32x2 a, f32x2 b, f32x2 c) { return __builtin_elementwise_fma(a, b, c); }
__device__ __forceinline__ float asub(float a, float b) { float d; asm("v_sub_f32 %0, %1, %2" : "=v"(d) : "v"(a), "v"(b)); return d; }

constexpr int D = 4096, NBATCH = 4, TSEQ = 2048, NMETA = 16, FF = 16384;
constexpr int MREAL = NBATCH * TSEQ;
constexpr int MROWS = MREAL + NMETA;
constexpr int RP = 8448;
constexpr int RW_H = 64, RW_N = 64;
constexpr int SB_H = 32, SB_D = 128;
constexpr float LN_EPS = 1e-5f, GN_EPS = 64e-5f;
constexpr float DN_ALPHA = 1.4142135623730951f;
constexpr float QSCALE = 0.08838834764831845f * 1.4426950408889634f;

namespace pg8 {
constexpr int BM = 256, BK = 64, HALF = 128, HTB = HALF * BK * 2, STAGE_BYTES = 8 * HTB, NXCD = 8, WGM = 8;
__host__ __device__ __forceinline__ int lds_byte(int r, int c) { const int st = (r >> 4) * 2 + (c >> 5), rr = r & 15, cc = c & 31, ob = rr * 64 + cc * 2; return st * 1024 + (ob ^ (((ob >> 9) & 1) << 5)); }
__host__ __device__ __forceinline__ void stage_rc(int b, int& R, int& C) { const int st = b / 1024, sb = b % 1024, swz = sb ^ (((sb >> 9) & 1) << 5); R = (st >> 1) * 16 + swz / 64; C = (st & 1) * 32 + (swz % 64) / 2; }
__host__ __device__ __forceinline__ int perm32(int rho) { const int n = rho >> 4, i = rho & 15; return 8 * (i >> 2) + 4 * n + (i & 3); }

struct Unit { int pm, pn; };
struct TileOrder {
    int nM, nN, nwg, G, c, nN2, nwg2;
    __device__ __forceinline__ void init(int nM_, int nN_, int G_, int c_, int nN2_ = 0) { nM = nM_; nN = nN_; nwg = nM * nN; G = G_; c = c_; nN2 = nN2_; nwg2 = nM * nN2_; }
    __device__ __forceinline__ bool next(int i, Unit& u) const {
        const long L = (long)i * G + c; if (L >= nwg + nwg2) return false;
        if (L >= nwg) { const int l2 = (int)L - nwg; u.pm = l2 % nM; u.pn = nN + l2 / nM; return true; }
        int wgid = (int)L; { const int q = nwg / NXCD, r = nwg % NXCD, xcd = wgid % NXCD, off = wgid / NXCD; wgid = (xcd < r ? xcd * (q + 1) : r * (q + 1) + (xcd - r) * q) + off; }
        const int nig = WGM * nN, gid = wgid / nig, fm = gid * WGM, gsz = (nM - fm) < WGM ? (nM - fm) : WGM;
        u.pm = fm + ((wgid % nig) % gsz); u.pn = (wgid % nig) / gsz; return true;
    }
};

template <class Prob, class Epi, bool ALIGN_EPI, bool SP2>
__device__ __forceinline__ void gemm_phase(LAS unsigned char* lds, const Prob& P, const Epi& E) {
    const int tid = threadIdx.x, wid = __builtin_amdgcn_readfirstlane(tid >> 6), lane = tid & 63, wr = wid >> 2, wc = wid & 3, fr = lane & 15, fq = lane >> 4;
    const int K = P.K;
    unsigned voffA[2], voffB[2];
#pragma unroll
    for (int i = 0; i < 2; ++i) { int R, C; stage_rc(tid * 16 + i * 8192, R, C); const int Rb = Epi::PERM ? ((R & ~31) + perm32(R & 31)) : R;
        voffA[i] = (unsigned)(R * K + C) * 2u; voffB[i] = (unsigned)(Rb * K + C) * 2u; }
    const size_t kstep = (size_t)(BK * 2);
    const size_t hstep = (size_t)HALF * K * 2;
    const unsigned ldsw = (unsigned)wid * 1024u;
    const int aoff = lds_byte(wr * 64 + fr, fq * 8), boff = lds_byte(wc * 32 + fr, fq * 8);
#define PG8_SA(b, h) (((b) * 2 + (h)) * HTB)
#define PG8_SB(b, h) ((4 + (b) * 2 + (h)) * HTB)
#define PG8_STAGE(bufoff, gbase, voff) do { _Pragma("unroll") for (int _i = 0; _i < 2; ++_i) \
        __builtin_amdgcn_global_load_lds((const unsigned*)((const char*)(gbase) + (voff)[_i]), (LAS unsigned*)(lds + (bufoff) + ldsw + _i * 8192), 16, 0, 0); } while (0)
#define PG8_LDA(dst, b, h) do { _Pragma("unroll") for (int m = 0; m < 4; ++m) _Pragma("unroll") for (int k = 0; k < 2; ++k) dst[m][k] = *(const LAS bf16x8*)(lds + PG8_SA(b, h) + aoff + m * 2048 + k * 1024); } while (0)
#define PG8_LDB(dst, b, h) do { _Pragma("unroll") for (int n = 0; n < 2; ++n) _Pragma("unroll") for (int k = 0; k < 2; ++k) dst[n][k] = *(const LAS bf16x8*)(lds + PG8_SB(b, h) + boff + n * 2048 + k * 1024); } while (0)
#define PG8_MMA(ai, bj, At, Bt) do { __builtin_amdgcn_s_setprio(1); _Pragma("unroll") for (int m = 0; m < 4; ++m) _Pragma("unroll") for (int n = 0; n < 2; ++n) _Pragma("unroll") for (int k = 0; k < 2; ++k) \
        acc[ai][bj][m][n] = __builtin_amdgcn_mfma_f32_16x16x32_bf16(Bt[n][k], At[m][k], acc[ai][bj][m][n], 0, 0, 0); __builtin_amdgcn_s_setprio(0); } while (0)
#define PG8_WAIT_V(n) asm volatile("s_waitcnt vmcnt(" #n ")" ::: "memory")
#define PG8_WAIT_L(n) asm volatile("s_waitcnt lgkmcnt(" #n ")" ::: "memory")
#define PG8_BAR __builtin_amdgcn_s_barrier()
#define PG8_SCHED __builtin_amdgcn_sched_barrier(0)
    Unit cur, nxt; int ui = 0;
    if (!P.S.next(0, cur)) return;
    f32x4 acc[2][2][4][2];
#pragma unroll
    for (int a = 0; a < 2; ++a)
#pragma unroll
        for (int b = 0; b < 2; ++b)
#pragma unroll
            for (int m = 0; m < 4; ++m)
#pragma unroll
                for (int n = 0; n < 2; ++n) acc[a][b][m][n] = (f32x4){0.f, 0.f, 0.f, 0.f};
    bf16x8 At[4][2], B0[2][2], B1[2][2];
    const char* cA = P.a_base(cur); const char* cB = P.b_base(cur);
    if constexpr (SP2) {
        PG8_STAGE(PG8_SB(0, 0), cB, voffB); PG8_STAGE(PG8_SB(0, 1), cB + hstep, voffB); PG8_STAGE(PG8_SA(0, 0), cA, voffA); PG8_STAGE(PG8_SA(0, 1), cA + hstep, voffA);
        if (wr == 1) PG8_BAR;
        PG8_WAIT_V(2); PG8_BAR;
        PG8_STAGE(PG8_SB(1, 0), cB + kstep, voffB); PG8_STAGE(PG8_SA(1, 0), cA + kstep, voffA); PG8_STAGE(PG8_SB(1, 1), cB + hstep + kstep, voffB);
        PG8_WAIT_V(6); PG8_BAR;
    } else {
        PG8_STAGE(PG8_SB(0, 0), cB, voffB); PG8_STAGE(PG8_SA(0, 0), cA, voffA); PG8_STAGE(PG8_SB(0, 1), cB + hstep, voffB); PG8_STAGE(PG8_SA(0, 1), cA + hstep, voffA);
        if (wr == 1) PG8_BAR;
        PG8_WAIT_V(4); PG8_BAR;
        PG8_STAGE(PG8_SB(1, 0), cB + kstep, voffB); PG8_STAGE(PG8_SA(1, 0), cA + kstep, voffA); PG8_STAGE(PG8_SB(1, 1), cB + hstep + kstep, voffB);
        PG8_WAIT_V(6); PG8_BAR;
    }
    for (;;) {
        const bool has_next = P.S.next(ui + 1, nxt);
        const char* nA = has_next ? P.a_base(nxt) : cA; const char* nB = has_next ? P.b_base(nxt) : cB;
        const int nt = P.nkt(cur);
        for (int t = 0; t < nt; t += 2) {
            const bool last = (t == nt - 2);
            const char* a1 = cA + (size_t)(t + 1) * kstep;
            const char* a2 = last ? nA : cA + (size_t)(t + 2) * kstep; const char* b2 = last ? nB : cB + (size_t)(t + 2) * kstep;
            const char* a3 = a2 + kstep; const char* b3 = b2 + kstep;
            if constexpr (SP2) {
            PG8_LDB(B0, 0, 0); PG8_LDB(B1, 0, 1); PG8_SCHED; PG8_LDA(At, 0, 0); PG8_STAGE(PG8_SA(1, 1), a1 + hstep, voffA);
            PG8_WAIT_V(8); PG8_WAIT_L(0); PG8_BAR; PG8_MMA(0, 0, At, B0); PG8_MMA(0, 1, At, B1); PG8_BAR; PG8_SCHED;
            PG8_LDA(At, 0, 1); PG8_STAGE(PG8_SB(0, 0), b2, voffB); PG8_STAGE(PG8_SB(0, 1), b2 + hstep, voffB); PG8_STAGE(PG8_SA(0, 0), a2, voffA);
            PG8_WAIT_V(8); PG8_WAIT_L(0); PG8_BAR; PG8_MMA(1, 0, At, B0); PG8_MMA(1, 1, At, B1); PG8_BAR; PG8_SCHED;
            PG8_LDB(B0, 1, 0); PG8_LDB(B1, 1, 1); PG8_SCHED; PG8_LDA(At, 1, 0); PG8_STAGE(PG8_SA(0, 1), a2 + hstep, voffA);
            PG8_WAIT_V(8); PG8_WAIT_L(0); PG8_BAR; PG8_MMA(0, 0, At, B0); PG8_MMA(0, 1, At, B1); PG8_BAR; PG8_SCHED;
            PG8_LDA(At, 1, 1); PG8_STAGE(PG8_SB(1, 0), b3, voffB); PG8_STAGE(PG8_SB(1, 1), b3 + hstep, voffB); PG8_STAGE(PG8_SA(1, 0), a3, voffA);
            PG8_WAIT_V(8); PG8_WAIT_L(0); PG8_BAR; PG8_MMA(1, 0, At, B0); PG8_MMA(1, 1, At, B1); PG8_BAR; PG8_SCHED;
            } else {
            PG8_LDB(B0, 0, 0); PG8_SCHED; PG8_LDA(At, 0, 0); PG8_STAGE(PG8_SA(1, 1), a1 + hstep, voffA);
            PG8_WAIT_L(8); PG8_BAR; PG8_WAIT_L(0); PG8_MMA(0, 0, At, B0); PG8_BAR; PG8_SCHED;
            PG8_LDB(B1, 0, 1); PG8_STAGE(PG8_SB(0, 0), b2, voffB);
            PG8_BAR; PG8_WAIT_L(0); PG8_MMA(0, 1, At, B1); PG8_BAR;
            PG8_LDA(At, 0, 1); PG8_STAGE(PG8_SA(0, 0), a2, voffA);
            PG8_BAR; PG8_WAIT_L(0); PG8_MMA(1, 0, At, B0); PG8_BAR; PG8_SCHED;
            PG8_STAGE(PG8_SB(0, 1), b2 + hstep, voffB);
            PG8_WAIT_V(6); PG8_BAR; PG8_MMA(1, 1, At, B1); PG8_BAR;
            PG8_LDB(B0, 1, 0); PG8_SCHED; PG8_LDA(At, 1, 0); PG8_STAGE(PG8_SA(0, 1), a2 + hstep, voffA);
            PG8_WAIT_L(8); PG8_BAR; PG8_WAIT_L(0); PG8_MMA(0, 0, At, B0); PG8_BAR; PG8_SCHED;
            PG8_LDB(B1, 1, 1); PG8_STAGE(PG8_SB(1, 0), b3, voffB);
            PG8_BAR; PG8_WAIT_L(0); PG8_MMA(0, 1, At, B1); PG8_BAR;
            PG8_LDA(At, 1, 1); PG8_STAGE(PG8_SA(1, 0), a3, voffA);
            PG8_BAR; PG8_WAIT_L(0); PG8_MMA(1, 0, At, B0); PG8_BAR; PG8_SCHED;
            PG8_STAGE(PG8_SB(1, 1), b3 + hstep, voffB);
            PG8_WAIT_V(6); PG8_BAR; PG8_MMA(1, 1, At, B1); PG8_BAR;
            }
        }
        if constexpr (ALIGN_EPI) { if (wr == 0) PG8_BAR; }
        E(acc, cur, wr, wc, fr, fq);
        if (!has_next) break;
#pragma unroll
        for (int a = 0; a < 2; ++a)
#pragma unroll
            for (int b = 0; b < 2; ++b)
#pragma unroll
                for (int m = 0; m < 4; ++m)
#pragma unroll
                    for (int n = 0; n < 2; ++n) acc[a][b][m][n] = (f32x4){0.f, 0.f, 0.f, 0.f};
        cur = nxt; cA = nA; cB = nB; ++ui;
        if constexpr (ALIGN_EPI) { if (wr == 1) PG8_BAR; }
    }
    PG8_WAIT_V(0);
    if constexpr (!ALIGN_EPI) { if (wr == 0) PG8_BAR; }
    PG8_BAR;
#undef PG8_SA
#undef PG8_SB
#undef PG8_STAGE
#undef PG8_LDA
#undef PG8_LDB
#undef PG8_MMA
#undef PG8_WAIT_V
#undef PG8_WAIT_L
#undef PG8_BAR
#undef PG8_SCHED
}
}
using pg8::Unit;

constexpr size_t MiB = (size_t)1 << 20;
constexpr size_t WS_CTL = 0, CTL_ZERO_BYTES = 1 * MiB;
constexpr size_t WS_W = 1 * MiB;
constexpr size_t W0_CAT = WS_W;
constexpr size_t W0_L2 = W0_CAT + 104 * MiB;
constexpr size_t W0_O = W0_L2 + 12 * MiB;
constexpr size_t W0_UP = W0_O + 32 * MiB;
constexpr size_t W0_DN = W0_UP + 128 * MiB;
constexpr size_t WS_X = WS_W + 404 * MiB;
constexpr size_t W1_QKV = WS_X;
constexpr size_t W1_O = W1_QKV + 96 * MiB;
constexpr size_t W1_UP = W1_O + 32 * MiB;
constexpr size_t W1_DN = W1_UP + 128 * MiB;
constexpr size_t ACT_BF = (size_t)RP * D * 2;
constexpr size_t ACT_F32 = (size_t)RP * D * 4;
constexpr size_t WS_Y = WS_X + 396 * MiB;
constexpr size_t WS_ZB = WS_Y, WS_HF = WS_Y + 132 * MiB, WS_HB = WS_Y + 264 * MiB;
constexpr size_t WS_Z = WS_Y + 396 * MiB;
constexpr size_t WS_L1O = WS_Z;
constexpr size_t L1O_BYTES = (size_t)3 * RP * 512 * 2;
constexpr size_t WS_WDEC = WS_Z + 25 * MiB, WS_AA = WS_WDEC + 132 * MiB, WS_GG = WS_AA + 132 * MiB, WS_YG = WS_GG + 66 * MiB;
constexpr size_t WS_QB = WS_Z, WS_KB = WS_Z + 66 * MiB, WS_VB = WS_Z + 132 * MiB, WS_OB = WS_Z + 198 * MiB;
constexpr size_t WS_U0 = WS_Z;
constexpr size_t WS_U1 = WS_W;
constexpr size_t WS_END = WS_Z + 421 * MiB;
static_assert(W1_DN + 128 * MiB <= WS_X + 396 * MiB && (size_t)RP * FF * 2 <= 404 * MiB && (size_t)RP * FF * 2 <= 421 * MiB && L1O_BYTES <= 25 * MiB && WS_YG + ACT_BF <= WS_END && W0_DN + 128 * MiB <= WS_X && 6 * ACT_BF <= 396 * MiB && 3 * ACT_F32 <= 396 * MiB, "ws map");
constexpr int CW_TMO = 0;
constexpr int CW_BAR = 4096;
constexpr size_t CTL_STATS = 512 * 1024;
constexpr size_t STATS_BYTES = (size_t)RP * 2 * 4;
static_assert(CTL_STATS + 4 * STATS_BYTES <= CTL_ZERO_BYTES, "stats inside the per-call memset");

constexpr int NWAVES = 8;
constexpr int RING_BYTES = 131072;
constexpr int LDSCTL_OFF = 153600, MISC_OFF = LDSCTL_OFF + 320;
constexpr int LDS_BYTES = 155648;

#define XB_TMO      128
#define XB_XCNT(j)  (256  + 64 * (j))
#define XB_XSUB(j)  (1280 + 64 * (j))
#define XB_XGEN(j)  (2304 + 64 * (j))
#define XB_TOP      3328
#define XB_TOPGEN   3392
#define XCD_BAR_WORDS 3456
#define XB_SPIN_CAP (1u << 18)
__device__ __forceinline__ unsigned xb_ld(unsigned* p)              { return __hip_atomic_load(p, __ATOMIC_RELAXED, __HIP_MEMORY_SCOPE_AGENT); }
__device__ __forceinline__ unsigned xb_add(unsigned* p, unsigned v) { return __hip_atomic_fetch_add(p, v, __ATOMIC_RELAXED, __HIP_MEMORY_SCOPE_AGENT); }
__device__ __forceinline__ unsigned xb_xcc_id() { return (unsigned)__builtin_amdgcn_s_getreg((3 << 11) | 20) & 0xFu; }
#define XB_SPIN(cond, bar) do { unsigned _sp = 0; while (cond) { __builtin_amdgcn_s_sleep(1); \
    if ((++_sp & 255u) == 0u) { if (xb_ld(&(bar)[XB_TMO])) break; if (_sp > XB_SPIN_CAP) { atomicAdd(&(bar)[XB_TMO], 1u); break; } } } } while (0)
struct XcdBarrier { unsigned* bar; unsigned x; volatile LAS unsigned* st; };
__device__ __forceinline__ XcdBarrier xcd_barrier_post(unsigned* bar, volatile LAS unsigned* st) {
    XcdBarrier b; b.bar = bar; b.x = xb_xcc_id(); b.st = st;
    if (threadIdx.x == 0) (void)xb_add(&bar[XB_XCNT(b.x)], 1u);
    return b;
}
__device__ __forceinline__ void xcd_barrier_complete(unsigned* bar, unsigned x, unsigned& nloc, unsigned& nx) {
    const unsigned G = gridDim.x * gridDim.y * gridDim.z;
    unsigned sum, cnt, mine, sp = 0u;
    for (;;) {
        sum = 0u; cnt = 0u; mine = 0u;
#pragma unroll
        for (unsigned j = 0; j < 16; ++j) { const unsigned c = xb_ld(&bar[XB_XCNT(j)]); sum += c; cnt += (c > 0u) ? 1u : 0u; mine = (j == x) ? c : mine; }
        if (sum == G) break;
        __builtin_amdgcn_s_sleep(1);
        if ((++sp & 255u) == 0u) { if (xb_ld(&bar[XB_TMO])) break; if (sp > XB_SPIN_CAP) { atomicAdd(&bar[XB_TMO], 1u); break; } }
    }
    nloc = mine > 0u ? mine : 1u; nx = cnt > 0u ? cnt : 1u;
}
__device__ __forceinline__ void xcd_barrier(const XcdBarrier& b) {
    asm volatile("s_waitcnt vmcnt(0)" ::: "memory");
    __syncthreads();
    if (threadIdx.x == 0) {
        unsigned* bar = b.bar;
        __builtin_amdgcn_s_waitcnt(0);
        unsigned nloc = b.st[0], nx = b.st[1];
        if (nloc == 0u) { xcd_barrier_complete(bar, b.x, nloc, nx); b.st[0] = nloc; b.st[1] = nx; }
        const unsigned old = xb_add(&bar[XB_XSUB(b.x)], 1u);
        const unsigned gen = old / nloc;
        if (old + 1u == (gen + 1u) * nloc) {
            __builtin_amdgcn_fence(__ATOMIC_RELEASE, "agent");
            asm volatile("s_waitcnt vmcnt(0)" ::: "memory");
            const unsigned og = xb_add(&bar[XB_TOP], 1u);
            const unsigned tg = og / nx;
            if (og + 1u == (tg + 1u) * nx) xb_add(&bar[XB_TOPGEN], 1u);
            else XB_SPIN(xb_ld(&bar[XB_TOPGEN]) == tg, bar);
            __builtin_amdgcn_fence(__ATOMIC_ACQUIRE, "agent");
            xb_add(&bar[XB_XGEN(b.x)], 1u);
            asm volatile("s_waitcnt vmcnt(0)" ::: "memory");
        } else {
            XB_SPIN(xb_ld(&bar[XB_XGEN(b.x)]) == gen, bar);
            __builtin_amdgcn_fence(__ATOMIC_ACQUIRE, "agent");
            asm volatile("s_waitcnt vmcnt(0)" ::: "memory");
        }
    }
    __syncthreads();
}

struct Params { const float* in[26]; float* out; unsigned char* ws; int ph_lo, ph_hi; };
enum { I_X = 0, I_META, I_LNMG, I_LNMB, I_LNFG, I_LNFB, I_WUP, I_WDN, I_MU, I_WRKV, I_W0, I_W1, I_W2, I_A0, I_A1, I_A2, I_G1, I_G2, I_KK, I_KA, I_RK, I_GNG, I_GNB, I_RWO, I_SBQKV, I_SBO };

struct Frame {
    LAS unsigned char* lds;
    int tid, lane, wave, vcu, G;
};
__device__ __forceinline__ float red16(float x) {
    x += __builtin_bit_cast(float, __builtin_amdgcn_update_dpp(0, __builtin_bit_cast(int, x), 0xB1, 0xF, 0xF, true));
    x += __builtin_bit_cast(float, __builtin_amdgcn_update_dpp(0, __builtin_bit_cast(int, x), 0x4E, 0xF, 0xF, true));
    x += __builtin_bit_cast(float, __builtin_amdgcn_update_dpp(0, __builtin_bit_cast(int, x), 0x141, 0xF, 0xF, true));
    x += __builtin_bit_cast(float, __builtin_amdgcn_update_dpp(0, __builtin_bit_cast(int, x), 0x140, 0xF, 0xF, true));
    return x;
}
template <int CTRL> __device__ __forceinline__ float dpp_mov(float v) { return __builtin_bit_cast(float, __builtin_amdgcn_update_dpp(0, __builtin_bit_cast(int, v), CTRL, 0xF, 0xF, true)); }
template <int CTRL> __device__ __forceinline__ f32x4 dpp_stage4(f32x4 x) { f32x4 t; t[0] = dpp_mov<CTRL>(x[0]); t[1] = dpp_mov<CTRL>(x[1]); t[2] = dpp_mov<CTRL>(x[2]); t[3] = dpp_mov<CTRL>(x[3]); return x + t; }
__device__ __forceinline__ f32x4 red16x4(f32x4 x) {
    float a = x[0], b = x[1], c = x[2], d = x[3];
#define R16_ROW(mod) "v_add_f32_dpp %0, %0, %0 " mod " row_mask:0xf bank_mask:0xf bound_ctrl:1\n\tv_add_f32_dpp %1, %1, %1 " mod " row_mask:0xf bank_mask:0xf bound_ctrl:1\n\t" \
                     "v_add_f32_dpp %2, %2, %2 " mod " row_mask:0xf bank_mask:0xf bound_ctrl:1\n\tv_add_f32_dpp %3, %3, %3 " mod " row_mask:0xf bank_mask:0xf bound_ctrl:1\n\t"
    asm volatile("s_nop 1\n\t" R16_ROW("quad_perm:[1,0,3,2]") R16_ROW("quad_perm:[2,3,0,1]") R16_ROW("row_half_mirror") R16_ROW("row_mirror") : "+v"(a), "+v"(b), "+v"(c), "+v"(d));
#undef R16_ROW
    return (f32x4){a, b, c, d};
}
__device__ __forceinline__ float wave_sum(float v) {
#pragma unroll
    for (int o = 1; o < 64; o <<= 1) v += __shfl_xor(v, o);
    return v;
}

__device__ __forceinline__ size_t hm_off(int row, int col) { return ((size_t)((row >> 11) * 64 + (col >> 6)) << 17) + (size_t)((row & 2047) * 64 + (col & 63)); }
__device__ __forceinline__ size_t hm_off_meta(int m, int col) { return (size_t)MREAL * D + (size_t)(((col >> 6) * 16 + m) * 64 + (col & 63)); }
struct ProbP1 {
    int K; pg8::TileOrder S; const char* mixed; const char* wcat;
    __device__ __forceinline__ const char* a_base(const Unit& u) const { const int gi = u.pn < 44 ? (u.pn >> 4) : (u.pn >= 48 ? 2 : (u.pn == 44 ? 3 : (u.pn == 45 ? 4 : 5)));
        return mixed + (size_t)gi * ACT_BF + (size_t)u.pm * 256 * D * 2 + (u.pn >= 48 ? (size_t)((u.pn - 48) & 1) * 4096 : (size_t)0); }
    __device__ __forceinline__ const char* b_base(const Unit& u) const { const int wt = u.pn < 44 ? u.pn : (u.pn < 48 ? u.pn + 4 : 44 + ((u.pn - 48) >> 1));
        return wcat + (size_t)wt * 256 * D * 2 + (u.pn >= 48 ? (size_t)((u.pn - 48) & 1) * 4096 : (size_t)0); }
    __device__ __forceinline__ int nkt(const Unit& u) const { return u.pn < 48 ? 64 : 32; }
};
struct EpiP1 {
    static constexpr bool PERM = false;
    bf16_t* rkv; bf16_t* l1o;
    __device__ __forceinline__ void operator()(const f32x4 (&acc)[2][2][4][2], const Unit& u, int wr, int wc, int fr, int fq) const {
        const int row0 = u.pm * 256 + wr * 64 + fr, c0 = wc * 32 + 4 * fq;
        if (u.pn < 44 || u.pn >= 48) {
            const int sub = u.pn < 44 ? (u.pn >> 4) : 2 + ((u.pn - 48) & 1), ct = u.pn < 44 ? (u.pn & 15) : 12 + ((u.pn - 48) >> 1);
            bf16_t* C = rkv + (size_t)sub * RP * D + hm_off(row0, ct * 256 + c0);
#pragma unroll
            for (int ai = 0; ai < 2; ++ai)
#pragma unroll
                for (int m = 0; m < 4; ++m) {
#pragma unroll
                    for (int bj = 0; bj < 2; ++bj)
#pragma unroll
                        for (int n = 0; n < 2; ++n) { const f32x4 v = acc[ai][bj][m][n]; u32x2 w; w.x = pk2(v[0], v[1]); w.y = pk2(v[2], v[3]); *(u32x2*)(C + (size_t)((ai * 128 + m * 16) * 64 + bj * (2 << 17) + n * 16)) = w; } }
        } else {
            const int lt = u.pn - 44, sub = lt < 2 ? lt : 2;
            bf16_t* O = l1o + (size_t)sub * RP * 512 + (lt == 3 ? 256 : 0) + c0;
#pragma unroll
            for (int ai = 0; ai < 2; ++ai)
#pragma unroll
                for (int m = 0; m < 4; ++m) { bf16_t* rowp = O + (size_t)(row0 + ai * 128 + m * 16) * 512;
#pragma unroll
                    for (int bj = 0; bj < 2; ++bj)
#pragma unroll
                        for (int n = 0; n < 2; ++n) { f32x4 v = acc[ai][bj][m][n];
                            if (sub == 0) {
#pragma unroll
                                for (int j = 0; j < 4; ++j) v[j] = 1.0f - 2.0f * frcp(fexp(2.0f * v[j]) + 1.0f);
                            } else if (sub == 2) {
#pragma unroll
                                for (int j = 0; j < 4; ++j) v[j] = fsigmoid(v[j]);
                            }
                            u32x2 w; w.x = pk2(v[0], v[1]); w.y = pk2(v[2], v[3]); *(u32x2*)(rowp + bj * 128 + n * 16) = w; } }
        }
    }
};
struct ProbL2 {
    int K; pg8::TileOrder S; const char* l1o; const char* w2;
    __device__ __forceinline__ const char* a_base(const Unit& u) const { return l1o + (size_t)(u.pn >> 4) * RP * 512 * 2 + (size_t)u.pm * 256 * 512 * 2; }
    __device__ __forceinline__ const char* b_base(const Unit& u) const { return w2 + (size_t)u.pn * 256 * 512 * 2; }
    __device__ __forceinline__ int nkt(const Unit& u) const { return (u.pn >> 4) < 2 ? 2 : 8; }
};
struct EpiL2 {
    static constexpr bool PERM = false;
    bf16_t* wdec; bf16_t* aa; bf16_t* gg; const float* w0; const float* a0;
    __device__ __forceinline__ void operator()(const f32x4 (&acc)[2][2][4][2], const Unit& u, int wr, int wc, int fr, int fq) const {
        const int row0 = u.pm * 256 + wr * 64 + fr, col0 = (u.pn & 15) * 256 + wc * 32 + 4 * fq, sub = u.pn >> 4;
        const size_t hbase = hm_off(row0, col0);
#pragma unroll
        for (int bj = 0; bj < 2; ++bj)
#pragma unroll
            for (int n = 0; n < 2; ++n) { const int col = col0 + bj * 128 + n * 16;
                f32x4 bias = (f32x4){0.f, 0.f, 0.f, 0.f};
                if (sub == 0) bias = *(const f32x4*)(w0 + col); else if (sub == 1) bias = *(const f32x4*)(a0 + col);
#pragma unroll
                for (int ai = 0; ai < 2; ++ai)
#pragma unroll
                    for (int m = 0; m < 4; ++m) { const size_t off = hbase + (size_t)((ai * 128 + m * 16) * 64 + bj * (2 << 17) + n * 16);
                        f32x4 v = acc[ai][bj][m][n] + bias;
                        if (sub == 0) {
#pragma unroll
                            for (int j = 0; j < 4; ++j) v[j] = 1.0f - fexp(-0.60653065971f * fsigmoid(v[j]));
                            { u32x2 w; w.x = pk2(v[0], v[1]); w.y = pk2(v[2], v[3]); *(u32x2*)(wdec + off) = w; }
                        } else if (sub == 1) {
#pragma unroll
                            for (int j = 0; j < 4; ++j) v[j] = fsigmoid(v[j]);
                            { u32x2 w; w.x = pk2(v[0], v[1]); w.y = pk2(v[2], v[3]); *(u32x2*)(aa + off) = w; }
                        } else { u32x2 w; w.x = pk2(v[0], v[1]); w.y = pk2(v[2], v[3]); *(u32x2*)(gg + off) = w; } } }
    }
};
struct ProbG {
    int K; pg8::TileOrder S; const char* A; const char* Bt;
    __device__ __forceinline__ const char* a_base(const Unit& u) const { return A + (size_t)u.pm * 256 * K * 2; }
    __device__ __forceinline__ const char* b_base(const Unit& u) const { return Bt + (size_t)u.pn * 256 * K * 2; }
    __device__ __forceinline__ int nkt(const Unit&) const { return K / 64; }
};
struct ProbQkv {
    int K; pg8::TileOrder S; const char* hb; const char* w;
    __device__ __forceinline__ const char* a_base(const Unit& u) const { return u.pn < 32 ? hb + (size_t)u.pm * 256 * D * 2 : w + (size_t)(8192 + (u.pn - 32) * 256) * D * 2; }
    __device__ __forceinline__ const char* b_base(const Unit& u) const { return u.pn < 32 ? w + (size_t)u.pn * 256 * D * 2 : hb + (size_t)u.pm * 256 * D * 2; }
    __device__ __forceinline__ int nkt(const Unit&) const { return D / 64; }
};
__device__ __forceinline__ void ln_row_stats(const float* st, int row, float& rho, float& nmr) {
    const float s1 = st[2 * row], s2 = st[2 * row + 1];
    const float mean = s1 * (1.0f / D), var = fmaxf(s2 * (1.0f / D) - mean * mean, 0.f);
    rho = __builtin_amdgcn_rsqf(var + LN_EPS); nmr = -mean * rho;
}
template <bool LNRES> struct EpiRes {
    static constexpr bool PERM = false;
    float* z; const float* res; const float* st_in; const float* g; const float* b; float* st_out;
    __device__ __forceinline__ void operator()(const f32x4 (&acc)[2][2][4][2], const Unit& u, int wr, int wc, int fr, int fq) const {
        const int row0 = u.pm * 256 + wr * 64 + fr, col0 = u.pn * 256 + wc * 32 + 4 * fq;
        f32x4 gv[2][2], bv[2][2];
        if (LNRES) {
#pragma unroll
            for (int bj = 0; bj < 2; ++bj)
#pragma unroll
                for (int n = 0; n < 2; ++n) { gv[bj][n] = *(const f32x4*)(g + col0 + bj * 128 + n * 16); bv[bj][n] = *(const f32x4*)(b + col0 + bj * 128 + n * 16); }
        }
#pragma unroll
        for (int ai = 0; ai < 2; ++ai)
#pragma unroll
            for (int m = 0; m < 4; ++m) { const int row = row0 + ai * 128 + m * 16;
                const float* rp = res + (size_t)row * D + col0;
                float* zp = z + (size_t)row * D + col0;
                float rho = 1.f, nmr = 0.f;
                if (LNRES) ln_row_stats(st_in, row, rho, nmr);
                float s1 = 0.f, s2 = 0.f;
#pragma unroll
                for (int bj = 0; bj < 2; ++bj)
#pragma unroll
                    for (int n = 0; n < 2; ++n) { f32x4 r = *(const f32x4*)(rp + bj * 128 + n * 16);
                        if (LNRES) r = (r * rho + nmr) * gv[bj][n] + bv[bj][n];
                        const f32x4 zz = r * DN_ALPHA + acc[ai][bj][m][n];
                        *(f32x4*)(zp + bj * 128 + n * 16) = zz;
                        s1 += (zz[0] + zz[1]) + (zz[2] + zz[3]); s2 += (zz[0] * zz[0] + zz[1] * zz[1]) + (zz[2] * zz[2] + zz[3] * zz[3]); }
                s1 += __shfl_xor(s1, 16); s2 += __shfl_xor(s2, 16); s1 += __shfl_xor(s1, 32); s2 += __shfl_xor(s2, 32);
                if (fq == 0) { atomicAdd(st_out + 2 * row, s1); atomicAdd(st_out + 2 * row + 1, s2); } }
    }
};
struct EpiUp {
    static constexpr bool PERM = true;
    bf16_t* O;
    __device__ __forceinline__ void operator()(const f32x4 (&acc)[2][2][4][2], const Unit& u, int wr, int wc, int fr, int fq) const {
        const int row0 = u.pm * 256 + wr * 64 + fr, col0 = u.pn * 256 + wc * 32 + 8 * fq;
#pragma unroll
        for (int ai = 0; ai < 2; ++ai)
#pragma unroll
            for (int m = 0; m < 4; ++m) { bf16_t* rowp = O + (size_t)(row0 + ai * 128 + m * 16) * FF + col0;
#pragma unroll
                for (int bj = 0; bj < 2; ++bj) { f32x4 v0 = acc[ai][bj][m][0], v1 = acc[ai][bj][m][1];
#pragma unroll
                    for (int j = 0; j < 4; ++j) { const float a = fmaxf(v0[j], 0.f), b = fmaxf(v1[j], 0.f); v0[j] = a * a; v1[j] = b * b; }
                    u32x4 w; w.x = pk2(v0[0], v0[1]); w.y = pk2(v0[2], v0[3]); w.z = pk2(v1[0], v1[1]); w.w = pk2(v1[2], v1[3]);
                    *(u32x4*)(rowp + bj * 128) = w; } }
    }
};
struct EpiQkv {
    static constexpr bool PERM = true;
    bf16_t* qb;
    __device__ __forceinline__ void operator()(const f32x4 (&acc)[2][2][4][2], const Unit& u, int wr, int wc, int fr, int fq) const {
        const int t = u.pn >> 4; const float sc = (t == 0) ? QSCALE : 1.0f;
        bf16_t* O; size_t ld;
        if (t < 2) { O = qb + (size_t)t * RP * D + (size_t)(u.pm * 256) * D + (u.pn & 15) * 256; ld = D; }
        else { O = qb + (size_t)2 * RP * D + (size_t)((u.pn - 32) * 256) * RP + u.pm * 256; ld = RP; }
        O += (size_t)(wr * 64 + fr) * ld + wc * 32 + 8 * fq;
#pragma unroll
        for (int ai = 0; ai < 2; ++ai)
#pragma unroll
            for (int m = 0; m < 4; ++m) { bf16_t* rowp = O + (size_t)(ai * 128 + m * 16) * ld;
#pragma unroll
                for (int bj = 0; bj < 2; ++bj) { const f32x4 v0 = acc[ai][bj][m][0] * sc, v1 = acc[ai][bj][m][1] * sc;
                    u32x4 w; w.x = pk2(v0[0], v0[1]); w.y = pk2(v0[2], v0[3]); w.z = pk2(v1[0], v1[1]); w.w = pk2(v1[2], v1[3]);
                    *(u32x4*)(rowp + bj * 128) = w; } }
    }
};

__device__ __forceinline__ void tr_item(const float* W, int K, int N, int nblk, bf16_t* WT, int Kp, LAS float* scr, int item, int lane) {
    const int kb = item / nblk, nb = item - kb * nblk, k0 = 64 * kb, n0 = 32 * nb;
    const int lr = lane >> 3, lc = (lane & 7) * 4;
    f32x4 v[8];
#pragma unroll
    for (int i = 0; i < 8; ++i) { const int k = k0 + lr + 8 * i, n = n0 + lc; v[i] = (k < K && n < N) ? *(const f32x4*)(W + (size_t)k * N + n) : (f32x4){0.f, 0.f, 0.f, 0.f}; }
#pragma unroll
    for (int i = 0; i < 8; ++i) { LAS float* s = scr + (lr + 8 * i) * 33 + lc; s[0] = v[i].x; s[1] = v[i].y; s[2] = v[i].z; s[3] = v[i].w; }
    asm volatile("s_waitcnt lgkmcnt(0)" ::: "memory");
    const int c = lane & 7;
#pragma unroll
    for (int j = 0; j < 4; ++j) { const int n = (lane >> 3) + 8 * j; const LAS float* s = scr + (8 * c) * 33 + n;
        u32x4 o; o.x = pk2(s[0], s[33]); o.y = pk2(s[66], s[99]); o.z = pk2(s[132], s[165]); o.w = pk2(s[198], s[231]);
        *(u32x4*)(WT + (size_t)(n0 + n) * Kp + k0 + 8 * c) = o; }
    asm volatile("s_waitcnt lgkmcnt(0)" ::: "memory");
}
struct TrJob { const float* W; int K, N, Kp, Np; bf16_t* WT; };
template <int NJ> __device__ __forceinline__ int tr_total(const TrJob (&J)[NJ]) { int t = 0;
#pragma unroll
    for (int j = 0; j < NJ; ++j) t += (J[j].Kp / 64) * (J[j].Np / 32);
    return t; }
template <int NJ> __device__ __forceinline__ void tr_jobs(const Frame& F, const TrJob (&J)[NJ]) {
    LAS float* scr = (LAS float*)(F.lds + F.wave * 8448);
    const int gw = F.vcu * NWAVES + F.wave, NGW = F.G * NWAVES;
    const int total = tr_total<NJ>(J);
    for (int it = gw; it < total; it += NGW) {
        int r = it;
#pragma unroll
        for (int j = 0; j < NJ; ++j) { const int n = (J[j].Kp / 64) * (J[j].Np / 32);
            if (r >= 0 && r < n) tr_item(J[j].W, J[j].K, J[j].N, J[j].Np / 32, J[j].WT, J[j].Kp, scr, r, F.lane);
            r -= n; }
    }
}
struct TrRef { const float* W; bf16_t* WT; int N, Kp; };
template <int NJ> __device__ __forceinline__ TrRef tr_lookup(const TrJob (&J)[NJ], int it) {
    TrRef R; R.W = J[0].W; R.WT = J[0].WT; R.N = 32; R.Kp = 64;
    int r = it;
#pragma unroll
    for (int j = 0; j < NJ; ++j) { const int nblk = J[j].Np / 32, n = (J[j].Kp / 64) * nblk;
        if (r >= 0 && r < n) { const int kb = r / nblk, nb = r - kb * nblk; R.N = J[j].N; R.Kp = J[j].Kp;
            R.W = J[j].W + (size_t)(64 * kb) * J[j].N + 32 * nb; R.WT = J[j].WT + (size_t)(32 * nb) * J[j].Kp + 64 * kb; }
        r -= n; }
    return R;
}
__device__ __forceinline__ void tr_load(const TrRef& R, int lane, f32x4 (&v)[8]) {
    const unsigned off = (unsigned)((2 * (lane >> 3)) * R.N + 4 * (lane & 7));
#pragma unroll
    for (int i = 0; i < 4; ++i) { const float* p = R.W + (size_t)(16 * i) * R.N; v[2 * i] = __builtin_nontemporal_load((const f32x4*)(p + off)); v[2 * i + 1] = __builtin_nontemporal_load((const f32x4*)(p + R.N + off)); }
}
__device__ __forceinline__ void tr_store(const TrRef& R, int lane, const f32x4 (&v)[8], LAS unsigned* scr) {
    const int lr = lane >> 3, lc = 4 * (lane & 7);
#pragma unroll
    for (int i = 0; i < 4; ++i)
#pragma unroll
        for (int q = 0; q < 4; ++q) scr[(lc + q) * 36 + 8 * i + lr] = pk2(v[2 * i][q], v[2 * i + 1][q]);
    asm volatile("s_waitcnt lgkmcnt(0)" ::: "memory");
    const unsigned off = (unsigned)((lane >> 3) * R.Kp + 8 * (lane & 7));
#pragma unroll
    for (int j = 0; j < 4; ++j) { const u32x4 o = *(const LAS u32x4*)(scr + ((lane >> 3) + 8 * j) * 36 + 4 * (lane & 7)); *(u32x4*)(R.WT + (size_t)(8 * j) * R.Kp + off) = o; }
    asm volatile("s_waitcnt lgkmcnt(0)" ::: "memory");
}
__device__ __forceinline__ void mix_phase(const Frame& F, const float* x, const float* meta, const float* mu, bf16_t* mixed) {
    const int gw = F.vcu * NWAVES + F.wave, NGW = F.G * NWAVES;
    for (int task = gw; task < 16 * 257; task += NGW) {
        const int cc = task & 15, rr = task >> 4, col = cc * 256 + F.lane * 4;
        const int row0 = rr < 256 ? rr * 32 : MREAL, nrows = rr < 256 ? 32 : NMETA;
        f32x4 m4[6];
#pragma unroll
        for (int n = 0; n < 6; ++n) m4[n] = *(const f32x4*)(mu + (size_t)n * D + col);
        f32x4 prev = (f32x4){0.f, 0.f, 0.f, 0.f};
        if (rr < 256) prev = ((row0 & (TSEQ - 1)) == 0) ? *(const f32x4*)(meta + (size_t)(NMETA - 1) * D + col) : *(const f32x4*)(x + (size_t)(row0 - 1) * D + col);
        const float* src = rr < 256 ? x + (size_t)row0 * D + col : meta + col;
#pragma unroll 4
        for (int i = 0; i < nrows; ++i) {
            const f32x4 h = *(const f32x4*)(src + (size_t)i * D);
            const f32x4 xx = prev - h;
#pragma unroll
            for (int n = 0; n < 6; ++n) { const f32x4 m = h + xx * m4[n]; u32x2 w; w.x = pk2(m[0], m[1]); w.y = pk2(m[2], m[3]);
                *(u32x2*)(mixed + (size_t)n * RP * D + (size_t)(row0 + i) * D + col) = w; }
            prev = h;
        }
    }
}
__device__ __forceinline__ void zero_bytes(const Frame& F, unsigned char* p, size_t nbytes) {
    const size_t n16 = nbytes / 16, stride = (size_t)F.G * NWAVES * 64;
    for (size_t i = (size_t)(F.vcu * NWAVES + F.wave) * 64 + F.lane; i < n16; i += stride) ((u32x4*)p)[i] = (u32x4){0u, 0u, 0u, 0u};
}
__device__ __forceinline__ void ln_apply(const Frame& F, const float* z, const float* st, const float* g, const float* b, bf16_t* hb, float* out, int nrows) {
    const int gw = F.vcu * NWAVES + F.wave, NGW = F.G * NWAVES;
    for (int row = gw; row < nrows; row += NGW) {
        float rho, nmr; ln_row_stats(st, row, rho, nmr);
        const f32x4* zr = (const f32x4*)(z + (size_t)row * D) + F.lane;
        f32x4 v[16];
#pragma unroll
        for (int j = 0; j < 16; ++j) v[j] = zr[64 * j];
#pragma unroll
        for (int j = 0; j < 16; ++j) { const int col = (64 * j + F.lane) * 4;
            const f32x4 o = (v[j] * rho + nmr) * *(const f32x4*)(g + col) + *(const f32x4*)(b + col);
            if (out) *(f32x4*)(out + (size_t)row * D + col) = o;
            if (hb) { u32x2 w; w.x = pk2(o[0], o[1]); w.y = pk2(o[2], o[3]); *(u32x2*)(hb + (size_t)row * D + col) = w; } }
    }
}
template <int STEPS, class SP> __device__ __forceinline__ void skinny_gemm(const Frame& F, int K, int ntiles, const SP& P) {
    LAS float* PS = (LAS float*)F.lds;
    const int lane = F.lane, r = lane & 15, kq = lane >> 4, kw = K >> 3;
    for (int t = F.vcu; t < ntiles; t += F.G) {
        const bf16_t* A; const bf16_t* B; int lda;
        P.tile(t, A, lda, B);
        const bf16_t* ap = A + (size_t)r * lda + F.wave * kw + kq * 8;
        const bf16_t* bp = B + (size_t)r * K + F.wave * kw + kq * 8;
        f32x4 acc = (f32x4){0.f, 0.f, 0.f, 0.f};
        for (int i0 = 0; i0 < kw; i0 += 32 * STEPS) {
            bf16x8 a[STEPS], b[STEPS];
#pragma unroll
            for (int i = 0; i < STEPS; ++i) { a[i] = *(const bf16x8*)(ap + i0 + 32 * i); b[i] = *(const bf16x8*)(bp + i0 + 32 * i); }
#pragma unroll
            for (int i = 0; i < STEPS; ++i) acc = __builtin_amdgcn_mfma_f32_16x16x32_bf16(a[i], b[i], acc, 0, 0, 0);
        }
#pragma unroll
        for (int j = 0; j < 4; ++j) PS[F.wave * 256 + (kq * 4 + j) * 16 + r] = acc[j];
        __syncthreads();
        if (F.tid < 256) { float v = 0.f;
#pragma unroll
            for (int w = 0; w < 8; ++w) v += PS[w * 256 + F.tid];
            P.out(t, F.tid >> 4, F.tid & 15, v); }
        __syncthreads();
    }
}
struct SkP1 {
    const bf16_t* mixed; const bf16_t* wcat; bf16_t* rkv; bf16_t* l1o;
    __device__ __forceinline__ int n0(int t) const { return t < 768 ? 16 * t : (t < 776 ? 12288 + 16 * (t - 768) : (t < 784 ? 12544 + 16 * (t - 776) : 12800 + 16 * (t - 784))); }
    __device__ __forceinline__ void tile(int t, const bf16_t*& A, int& lda, const bf16_t*& B) const {
        const int gi = t < 768 ? t >> 8 : (t < 776 ? 3 : (t < 784 ? 4 : 5));
        A = mixed + (size_t)gi * RP * D + (size_t)MREAL * D; lda = D; B = wcat + (size_t)n0(t) * D; }
    __device__ __forceinline__ void out(int t, int row, int c, float v) const {
        if (t < 768) rkv[(size_t)(t >> 8) * RP * D + hm_off_meta(row, 16 * (t & 255) + c)] = (bf16_t)(pk2(v, 0.f) & 0xffffu);
        else if (t < 776) l1o[(size_t)(MREAL + row) * 512 + 16 * (t - 768) + c] = (bf16_t)(pk2(1.0f - 2.0f * frcp(fexp(2.0f * v) + 1.0f), 0.f) & 0xffffu);
        else if (t < 784) l1o[(size_t)RP * 512 + (size_t)(MREAL + row) * 512 + 16 * (t - 776) + c] = (bf16_t)(pk2(v, 0.f) & 0xffffu);
        else l1o[(size_t)2 * RP * 512 + (size_t)(MREAL + row) * 512 + 16 * (t - 784) + c] = (bf16_t)(pk2(fsigmoid(v), 0.f) & 0xffffu);
    }
};
struct SkL2 {
    const bf16_t* l1o; const bf16_t* w2; bf16_t* wdec; bf16_t* aa; bf16_t* gg; const float* w0; const float* a0;
    __device__ __forceinline__ void tile(int t, const bf16_t*& A, int& lda, const bf16_t*& B) const { A = l1o + (size_t)(t >> 8) * RP * 512 + (size_t)MREAL * 512; lda = 512; B = w2 + (size_t)16 * t * 512; }
    __device__ __forceinline__ void out(int t, int row, int c, float v) const {
        const int sub = t >> 8, col = 16 * (t & 255) + c; const size_t off = hm_off_meta(row, col);
        if (sub == 0) wdec[off] = (bf16_t)(pk2(1.0f - fexp(-0.60653065971f * fsigmoid(v + w0[col])), 0.f) & 0xffffu);
        else if (sub == 1) aa[off] = (bf16_t)(pk2(fsigmoid(v + a0[col]), 0.f) & 0xffffu);
        else gg[off] = (bf16_t)(pk2(v, 0.f) & 0xffffu);
    }
};
template <bool LNRES> struct SkRes {
    const bf16_t* A_; int lda_; const bf16_t* Bt; int K; float* z; const float* res; const float* st_in; const float* g; const float* b; float* st_out;
    __device__ __forceinline__ void tile(int t, const bf16_t*& A, int& lda, const bf16_t*& B) const { A = A_; lda = lda_; B = Bt + (size_t)16 * t * K; }
    __device__ __forceinline__ void out(int t, int row, int c, float v) const { const int col = 16 * t + c; const size_t off = (size_t)row * D + col;
        float r = res[off];
        if (LNRES) { float rho, nmr; ln_row_stats(st_in, MREAL + row, rho, nmr); r = (r * rho + nmr) * g[col] + b[col]; }
        const float zz = DN_ALPHA * r + v; z[off] = zz;
        const float s1 = red16(zz), s2 = red16(zz * zz);
        if (c == 0) { atomicAdd(st_out + 2 * (MREAL + row), s1); atomicAdd(st_out + 2 * (MREAL + row) + 1, s2); } }
};
struct SkUp {
    const bf16_t* hb; const bf16_t* Bt; bf16_t* u;
    __device__ __forceinline__ void tile(int t, const bf16_t*& A, int& lda, const bf16_t*& B) const { A = hb; lda = D; B = Bt + (size_t)16 * t * D; }
    __device__ __forceinline__ void out(int t, int row, int c, float v) const { const float a = fmaxf(v, 0.f); u[(size_t)row * FF + 16 * t + c] = (bf16_t)(pk2(a * a, 0.f) & 0xffffu); }
};
struct SkKv {
    const bf16_t* hb; const bf16_t* Bt; bf16_t* kb;
    __device__ __forceinline__ void tile(int t, const bf16_t*& A, int& lda, const bf16_t*& B) const { A = hb; lda = D; B = Bt + (size_t)16 * t * D; }
    __device__ __forceinline__ void out(int t, int row, int c, float v) const {
        if (t < 256) kb[(size_t)row * D + 16 * t + c] = (bf16_t)(pk2(v, 0.f) & 0xffffu);
        else (kb - (size_t)MREAL * D + (size_t)RP * D)[(size_t)(16 * (t - 256) + c) * RP + MREAL + row] = (bf16_t)(pk2(v, 0.f) & 0xffffu); }
};

constexpr int SC_SET = 40960 + 8192 + 512 + 4096;
constexpr int SC_RDY = 0, SC_VB = 40960, SC_SCL = 49152, SC_GB = 49664;
constexpr int SC_YR = 2 * SC_SET;
struct ScanArgs { const bf16_t* r; const bf16_t* k; const bf16_t* v; const bf16_t* v2; const bf16_t* w; const bf16_t* a; const bf16_t* g; bf16_t* yg;
                  const float* k_k; const float* k_a; const float* r_k; const float* gn_g; const float* gn_b; };
constexpr int SC_SIDE = SC_YR + 16384;
static_assert(SC_SIDE + 4 * 4608 <= LDSCTL_OFF, "scan LDS map");
__device__ __forceinline__ f32x4 red8x4(f32x4 x) {
    float a = x[0], b = x[1], c = x[2], d = x[3];
#define R8_ROW(mod) "v_add_f32_dpp %0, %0, %0 " mod " row_mask:0xf bank_mask:0xf bound_ctrl:1\n\tv_add_f32_dpp %1, %1, %1 " mod " row_mask:0xf bank_mask:0xf bound_ctrl:1\n\t" \
                    "v_add_f32_dpp %2, %2, %2 " mod " row_mask:0xf bank_mask:0xf bound_ctrl:1\n\tv_add_f32_dpp %3, %3, %3 " mod " row_mask:0xf bank_mask:0xf bound_ctrl:1\n\t"
    asm volatile("s_nop 1\n\t" R8_ROW("quad_perm:[1,0,3,2]") R8_ROW("quad_perm:[2,3,0,1]") R8_ROW("row_half_mirror") : "+v"(a), "+v"(b), "+v"(c), "+v"(d));
#undef R8_ROW
    return (f32x4){a, b, c, d};
}
template <bool SIDE, int NJ> __device__ __forceinline__ void scan_role(const Frame& F, const ScanArgs& A, const TrJob (&J)[NJ]) {
    LAS float* YR = (LAS float*)(F.lds + SC_YR);
    const int tid = F.tid, lane = F.lane, w = F.wave;
    const int tt = tid >> 4, j4 = (tid & 15) * 4;
    const int ptt = (tid & 255) >> 4;
    const int c8 = (lane & 7) * 8, i0 = 16 * (w & 3) + 2 * (lane >> 3);
    LAS unsigned* sscr = (LAS unsigned*)(F.lds + SC_SIDE + (w & 3) * 4608);
    const int side_total = tr_total<NJ>(J), gsw = F.vcu * 4 + (w & 3), NSW = F.G * 4;
    int side_next = gsw;
    TrRef SR0 = tr_lookup<NJ>(J, 0), SR1 = SR0, SR2 = SR0; bool sh0 = false, sh1 = false, sh2 = false;
    f32x4 sv0[8], sv1[8], sv2[8];
    for (int bh = blockIdx.x; bh < NBATCH * RW_H; bh += F.G) {
        const int b = bh >> 6, h = bh & 63, col = h * 64 + j4;
        f32x2 S0[4], S1[4];
#pragma unroll
        for (int q = 0; q < 4; ++q) { S0[q] = (f32x2){0.f, 0.f}; S1[q] = (f32x2){0.f, 0.f}; }
        u32x2 qr[2], qk[2], qv[2], qw[2], qa[2], qg[2], qv2[2];
#define SC_OFF(c_, t_) ((c_) == 0 ? hm_off_meta((t_) & 15, col) : hm_off(b * TSEQ + ((c_) - 1) * 32 + (t_), col))
#define SC_LOAD(c_) do { _Pragma("unroll") for (int k = 0; k < 2; ++k) { const size_t off = SC_OFF(c_, ptt + 16 * k); \
            qr[k] = *(const u32x2*)(A.r + off); qk[k] = *(const u32x2*)(A.k + off); qv[k] = *(const u32x2*)(A.v + off); qw[k] = *(const u32x2*)(A.w + off); qa[k] = *(const u32x2*)(A.a + off); qg[k] = *(const u32x2*)(A.g + off); \
            qv2[k] = (h >= 48 && (c_) > 0) ? *(const u32x2*)(A.v2 + off) : (u32x2){0u, 0u}; } } while (0)
#define SC_PREP(set_) do { LAS unsigned char* sb = F.lds + (set_) * SC_SET; \
            const f32x4 ckk = *(const f32x4*)(A.k_k + col), cka = *(const f32x4*)(A.k_a + col), crk = *(const f32x4*)(A.r_k + col); \
            _Pragma("unroll") for (int k = 0; k < 2; ++k) { const int t_ = ptt + 16 * k; \
                const f32x4 pr = {bf_lo(qr[k].x), bf_hi(qr[k].x), bf_lo(qr[k].y), bf_hi(qr[k].y)}, pk = {bf_lo(qk[k].x), bf_hi(qk[k].x), bf_lo(qk[k].y), bf_hi(qk[k].y)}; \
                const f32x4 pv = {bf_lo(qv[k].x) + bf_lo(qv2[k].x), bf_hi(qv[k].x) + bf_hi(qv2[k].x), bf_lo(qv[k].y) + bf_lo(qv2[k].y), bf_hi(qv[k].y) + bf_hi(qv2[k].y)}; \
                const f32x4 pw = {1.0f - bf_lo(qw[k].x), 1.0f - bf_hi(qw[k].x), 1.0f - bf_lo(qw[k].y), 1.0f - bf_hi(qw[k].y)}, pa = {bf_lo(qa[k].x), bf_hi(qa[k].x), bf_lo(qa[k].y), bf_hi(qa[k].y)}; \
                const f32x4 kx = pk * ckk; const f32x4 kp = pk * ((pa - 1.0f) * cka + 1.0f); const f32x4 kxa = kx * pa, rkp = pr * kp; \
                f32x4 red; red[0] = (kx[0] * kx[0] + kx[1] * kx[1]) + (kx[2] * kx[2] + kx[3] * kx[3]); red[1] = (kxa[0] * pr[0] + kxa[1] * pr[1]) + (kxa[2] * pr[2] + kxa[3] * pr[3]); \
                red[2] = (rkp[0] + rkp[1]) + (rkp[2] + rkp[3]); red[3] = (rkp[0] * crk[0] + rkp[1] * crk[1]) + (rkp[2] * crk[2] + rkp[3] * crk[3]); \
                red = red16x4(red); \
                const float inv = __builtin_amdgcn_rsqf(fmaxf(red[0], 1e-24f)); \
                const f32x4 kk = kx * inv; const f32x4 bb = -(kk * pa); const f32x4 wr4 = pw * pr; \
                LAS float* rd = (LAS float*)(sb + SC_RDY) + t_ * 320 + j4; \
                *(LAS f32x4*)(rd) = kk; *(LAS f32x4*)(rd + 64) = wr4; *(LAS f32x4*)(rd + 128) = pw; *(LAS f32x4*)(rd + 192) = bb; *(LAS f32x4*)(rd + 256) = kp; \
                *(LAS f32x4*)((LAS float*)(sb + SC_VB) + t_ * 64 + j4) = pv; \
                *(LAS u32x2*)((LAS bf16_t*)(sb + SC_GB) + t_ * 64 + j4) = qg[k]; \
                if ((tid & 15) == 0) *(LAS f32x4*)((LAS float*)(sb + SC_SCL) + t_ * 4) = (f32x4){-inv * red[1], red[2], red[3], 0.f}; } } while (0)
        if constexpr (SIDE) { SC_LOAD(0); SC_PREP(0); SC_LOAD(1); }
        __syncthreads();
        for (int c = 0; c <= 64; ++c) {
            const int nsteps = c == 0 ? NMETA : 32;
            const int rowbase = c == 0 ? MREAL : b * TSEQ + (c - 1) * 32;
            LAS unsigned char* sb = F.lds + (c & 1) * SC_SET;
            if constexpr (!SIDE) {
                const LAS float* RDY = (const LAS float*)(sb + SC_RDY); const LAS float* VB = (const LAS float*)(sb + SC_VB);
                const LAS float* rd = RDY + c8;
                f32x4 kkA = *(const LAS f32x4*)(rd), kkB = *(const LAS f32x4*)(rd + 4), wrA = *(const LAS f32x4*)(rd + 64), wrB = *(const LAS f32x4*)(rd + 68), wA = *(const LAS f32x4*)(rd + 128), wB = *(const LAS f32x4*)(rd + 132);
                f32x4 bA = *(const LAS f32x4*)(rd + 192), bB = *(const LAS f32x4*)(rd + 196), kpA = *(const LAS f32x4*)(rd + 256), kpB = *(const LAS f32x4*)(rd + 260);
                f32x2 v2 = *(const LAS f32x2*)(VB + i0);
#pragma unroll 2
                for (int s = 0; s < nsteps; ++s) {
                    const int sn = (s + 1 < nsteps) ? s + 1 : s;
                    const LAS float* rn = RDY + sn * 320 + c8;
                    const f32x4 nkkA = *(const LAS f32x4*)(rn), nkkB = *(const LAS f32x4*)(rn + 4), nwrA = *(const LAS f32x4*)(rn + 64), nwrB = *(const LAS f32x4*)(rn + 68), nwA = *(const LAS f32x4*)(rn + 128), nwB = *(const LAS f32x4*)(rn + 132);
                    const f32x4 nbA = *(const LAS f32x4*)(rn + 192), nbB = *(const LAS f32x4*)(rn + 196), nkpA = *(const LAS f32x4*)(rn + 256), nkpB = *(const LAS f32x4*)(rn + 260);
                    const f32x2 nv = *(const LAS f32x2*)(VB + sn * 64 + i0);
                    const f32x2 kkv[4] = {{kkA[0], kkA[1]}, {kkA[2], kkA[3]}, {kkB[0], kkB[1]}, {kkB[2], kkB[3]}}, wrv[4] = {{wrA[0], wrA[1]}, {wrA[2], wrA[3]}, {wrB[0], wrB[1]}, {wrB[2], wrB[3]}};
                    const f32x2 wv[4] = {{wA[0], wA[1]}, {wA[2], wA[3]}, {wB[0], wB[1]}, {wB[2], wB[3]}}, bv[4] = {{bA[0], bA[1]}, {bA[2], bA[3]}, {bB[0], bB[1]}, {bB[2], bB[3]}};
                    const f32x2 kpv[4] = {{kpA[0], kpA[1]}, {kpA[2], kpA[3]}, {kpB[0], kpB[1]}, {kpB[2], kpB[3]}};
                    f32x2 d0 = S0[0] * kkv[0], d1 = S1[0] * kkv[0], d2 = S0[0] * wrv[0], d3 = S1[0] * wrv[0];
#pragma unroll
                    for (int q = 1; q < 4; ++q) { d0 = pfma2(S0[q], kkv[q], d0); d1 = pfma2(S1[q], kkv[q], d1); d2 = pfma2(S0[q], wrv[q], d2); d3 = pfma2(S1[q], wrv[q], d3); }
                    f32x4 dd; dd[0] = d0[0] + d0[1]; dd[1] = d1[0] + d1[1]; dd[2] = d2[0] + d2[1]; dd[3] = d3[0] + d3[1];
                    const f32x2 v0 = {v2[0], v2[0]}, v1 = {v2[1], v2[1]};
                    f32x2 T0[4], T1[4];
#pragma unroll
                    for (int q = 0; q < 4; ++q) { T0[q] = pfma2(S0[q], wv[q], v0 * kpv[q]); T1[q] = pfma2(S1[q], wv[q], v1 * kpv[q]); }
                    dd = red8x4(dd);
                    const f32x2 p0 = {dd[0], dd[0]}, p1 = {dd[1], dd[1]};
#pragma unroll
                    for (int q = 0; q < 4; ++q) { S0[q] = pfma2(p0, bv[q], T0[q]); S1[q] = pfma2(p1, bv[q], T1[q]); }
                    if ((lane & 7) == 0) *(LAS f32x4*)(YR + s * 128 + i0 * 2) = dd;
                    kkA = nkkA; kkB = nkkB; wrA = nwrA; wrB = nwrB; wA = nwA; wB = nwB; bA = nbA; bB = nbB; kpA = nkpA; kpB = nkpB; v2 = nv;
                }
            } else {
                if (sh0) tr_store(SR0, lane, sv0, sscr);
                if (sh1) tr_store(SR1, lane, sv1, sscr);
                if (sh2) tr_store(SR2, lane, sv2, sscr);
                sh0 = side_next < side_total; if (sh0) { SR0 = tr_lookup<NJ>(J, side_next); tr_load(SR0, lane, sv0); side_next += NSW; }
                sh1 = side_next < side_total; if (sh1) { SR1 = tr_lookup<NJ>(J, side_next); tr_load(SR1, lane, sv1); side_next += NSW; }
                sh2 = side_next < side_total; if (sh2) { SR2 = tr_lookup<NJ>(J, side_next); tr_load(SR2, lane, sv2); side_next += NSW; }
                if (c < 64) { SC_PREP((c + 1) & 1); if (c < 63) SC_LOAD(c + 2); }
            }
            __syncthreads();
            if (tt < nsteps && (c > 0 || b == 0)) {
                const f32x4 ya = *(const LAS f32x4*)(YR + tt * 128 + j4 * 2), yb = *(const LAS f32x4*)(YR + tt * 128 + j4 * 2 + 4);
                const f32x4 sc = *(const LAS f32x4*)((const LAS float*)(sb + SC_SCL) + tt * 4);
                const f32x4 vk = *(const LAS f32x4*)((const LAS float*)(sb + SC_VB) + tt * 64 + j4);
                const u32x2 pg = *(const LAS u32x2*)((const LAS bf16_t*)(sb + SC_GB) + tt * 64 + j4);
                const f32x4 cgg = *(const f32x4*)(A.gn_g + col), cgb = *(const f32x4*)(A.gn_b + col);
                f32x4 y4;
                y4[0] = ya[2] + ya[0] * sc[0] + vk[0] * sc[1]; y4[1] = ya[3] + ya[1] * sc[0] + vk[1] * sc[1];
                y4[2] = yb[2] + yb[0] * sc[0] + vk[2] * sc[1]; y4[3] = yb[3] + yb[1] * sc[0] + vk[3] * sc[1];
                const float mu = red16((y4[0] + y4[1]) + (y4[2] + y4[3])) * (1.0f / 64.0f);
                const f32x4 d = y4 - mu;
                const float var = red16((d[0] * d[0] + d[1] * d[1]) + (d[2] * d[2] + d[3] * d[3])) * (1.0f / 64.0f);
                const float rstd = __builtin_amdgcn_rsqf(var + GN_EPS);
                f32x4 o = d * rstd * cgg + cgb + vk * sc[2];
                o[0] *= bf_lo(pg.x); o[1] *= bf_hi(pg.x); o[2] *= bf_lo(pg.y); o[3] *= bf_hi(pg.y);
                u32x2 wv; wv.x = pk2(o[0], o[1]); wv.y = pk2(o[2], o[3]);
                *(u32x2*)(A.yg + (size_t)(rowbase + tt) * D + col) = wv;
            }
            __syncthreads();
        }
#undef SC_OFF
#undef SC_LOAD
#undef SC_PREP
    }
    if constexpr (SIDE) {
        if (sh0) tr_store(SR0, lane, sv0, sscr);
        if (sh1) tr_store(SR1, lane, sv1, sscr);
        if (sh2) tr_store(SR2, lane, sv2, sscr);
        for (int it = side_next; it < side_total; it += NSW) {
            const TrRef R = tr_lookup<NJ>(J, it); f32x4 v[8]; tr_load(R, lane, v); tr_store(R, lane, v, sscr); }
    }
}
template <int NJ> __device__ __forceinline__ void scan_phase(const Frame& F, const ScanArgs& A, const TrJob (&J)[NJ]) {
    if (F.wave < 4) scan_role<false, NJ>(F, A, J); else scan_role<true, NJ>(F, A, J);
}

constexpr int AT_KT = 0;
constexpr int AT_VT = 32768;
constexpr int AT_QS = 65536;
#define MFMA32(a, b, c) __builtin_amdgcn_mfma_f32_32x32x16_bf16((a), (b), (c), 0, 0, 0)
typedef _Float16 f16x8 __attribute__((ext_vector_type(8)));
typedef _Float16 f16x2 __attribute__((ext_vector_type(2)));
__device__ __forceinline__ unsigned pkh2(float lo, float hi) { f32x2 v = {lo, hi}; return __builtin_bit_cast(unsigned, __builtin_convertvector(v, f16x2)); }
__device__ __forceinline__ void attn_phase(const Frame& F, const bf16_t* qb, const bf16_t* kb, const bf16_t* vt, bf16_t* ob) {
    const int lane = F.lane, w = F.wave, c = lane & 31, h = lane >> 5;
    LAS unsigned char* KT = F.lds + AT_KT; LAS unsigned char* VT = F.lds + AT_VT;
    f16x8 U[2];
#pragma unroll
    for (int s = 0; s < 2; ++s)
#pragma unroll
        for (int j = 0; j < 8; ++j) { const int kin = 16 * s + 8 * (j >> 2) + 4 * h + (j & 3); U[s][j] = kin >= c ? (_Float16)-1.0f : (_Float16)0.0f; }
    const int dk_key = 4 * w + (lane >> 4), dk_ch = (lane & 15) ^ (dk_key & 15);
    const int dv_d = 16 * w + (lane >> 2), dv_ch = (lane & 3) ^ ((dv_d >> 2) & 3);
    for (int unit = blockIdx.x; unit < NBATCH * SB_H * 4; unit += F.G) {
        const int bh = unit >> 2, pr = unit & 3, b = bh >> 5, hh = bh & 31;
        const bf16_t* kcol = kb + hh * SB_D + dk_ch * 8;
        const bf16_t* vrow = vt + (size_t)(hh * SB_D + dv_d) * RP + dv_ch * 8;
        for (int half = 0; half < 2; ++half) {
            const int Q0 = (half == 0 ? 7 - pr : pr) * 256, q0 = Q0 + 32 * w, diag = q0 >> 5;
            const size_t qrow = (size_t)b * TSEQ + q0 + c;
            LAS unsigned char* QS = F.lds + AT_QS + w * 8192 + c * 256;
#pragma unroll
            for (int ks = 0; ks < 8; ++ks) *(LAS bf16x8*)(QS + (((2 * ks + h) ^ (c & 15)) * 16)) = *(const bf16x8*)(qb + qrow * D + hh * SB_D + 16 * ks + 8 * h);
            f32x16 O[4];
#pragma unroll
            for (int dt = 0; dt < 4; ++dt)
#pragma unroll
                for (int i = 0; i < 16; ++i) O[dt][i] = 0.f;
            float carry = 0.f;
            const int stmax = (Q0 >> 5) + 7, nstg = stmax + 2;
#define AT_DMA(n_) do { const int n__ = (n_); const int slot = n__ & 3; const bool mt = (n__ == nstg - 1); \
                const size_t tok = mt ? (size_t)MREAL : (size_t)b * TSEQ + 32 * (stmax - n__); \
                const bf16_t* ksrc = kcol + (tok + (mt ? (dk_key & 15) : dk_key)) * D; \
                const bf16_t* vsrc = mt ? (vrow - dv_ch * 8 + (dv_ch & 1) * 8 + tok) : (vrow + tok); \
                __builtin_amdgcn_global_load_lds((const unsigned*)ksrc, (LAS unsigned*)(KT + slot * 8192 + w * 1024), 16, 0, 0); \
                __builtin_amdgcn_global_load_lds((const unsigned*)vsrc, (LAS unsigned*)(VT + slot * 8192 + w * 1024), 16, 0, 0); } while (0)
            AT_DMA(0); AT_DMA(1); AT_DMA(2);
            for (int n = 0; n < nstg; ++n) {
                const int rem = nstg - 1 - n;
                if (rem >= 2) asm volatile("s_waitcnt vmcnt(4)" ::: "memory"); else if (rem == 1) asm volatile("s_waitcnt vmcnt(2)" ::: "memory"); else asm volatile("s_waitcnt vmcnt(0)" ::: "memory");
                __builtin_amdgcn_s_barrier();
                asm volatile("" ::: "memory");
                if (n + 3 < nstg) AT_DMA(n + 3);
                const LAS unsigned char* KTb = KT + (n & 3) * 8192; const LAS unsigned char* VTb = VT + (n & 3) * 8192;
                const bool meta = (n == nstg - 1);
                const int st_abs = stmax - n;
                if (meta || st_abs <= diag) {
                    const int limit = meta ? NMETA : ((st_abs == diag) ? c : 64);
                    f32x16 Z;
#pragma unroll
                    for (int i = 0; i < 16; ++i) Z[i] = 0.f;
#pragma unroll
                    for (int ks = 0; ks < 8; ++ks) { const bf16x8 a = *(const LAS bf16x8*)(KTb + c * 256 + (((2 * ks + h) ^ (c & 15)) * 16)); const bf16x8 qf = *(const LAS bf16x8*)(QS + (((2 * ks + h) ^ (c & 15)) * 16)); Z = MFMA32(a, qf, Z); }
                    f32x16 X, Y;
#pragma unroll
                    for (int i = 0; i < 16; ++i) X[i] = flog2(1.0f + fexp2(fminf(Z[i], 100.f)));
                    if (limit < 64) {
#pragma unroll
                        for (int i = 0; i < 16; ++i) { const int row = (i & 3) + 8 * (i >> 2) + 4 * h; X[i] = row < limit ? X[i] : 0.f; }
                    }
#pragma unroll
                    for (int i = 0; i < 16; ++i) Y[i] = Z[i] + carry;
                    f16x8 Xh[2];
#pragma unroll
                    for (int s = 0; s < 2; ++s) { u32x4 hu;
#pragma unroll
                        for (int jj = 0; jj < 4; ++jj) hu[jj] = pkh2(X[8 * s + 2 * jj], X[8 * s + 2 * jj + 1]);
                        Xh[s] = __builtin_bit_cast(f16x8, hu); }
                    Y = __builtin_amdgcn_mfma_f32_32x32x16_f16(U[0], Xh[0], Y, 0, 0, 0); Y = __builtin_amdgcn_mfma_f32_32x32x16_f16(U[1], Xh[1], Y, 0, 0, 0);
                    carry = __shfl(Y[0] - Z[0], c);
#pragma unroll
                    for (int i = 0; i < 16; ++i) Y[i] = fexp2(Y[i]);
                    if (limit < 64) {
#pragma unroll
                        for (int i = 0; i < 16; ++i) { const int row = (i & 3) + 8 * (i >> 2) + 4 * h; Y[i] = row < limit ? Y[i] : 0.f; }
                    }
                    bf16x8 Pb[2];
#pragma unroll
                    for (int s = 0; s < 2; ++s) { u32x4 pu;
#pragma unroll
                        for (int jj = 0; jj < 4; ++jj) pu[jj] = pk2(Y[8 * s + 2 * jj], Y[8 * s + 2 * jj + 1]);
                        Pb[s] = __builtin_bit_cast(bf16x8, pu); }
#pragma unroll
                    for (int dt = 0; dt < 4; ++dt) { const int d = 32 * dt + c; const LAS unsigned char* rowp = VTb + d * 64 + 8 * h; const int sw = (d >> 2) & 3;
#pragma unroll
                        for (int s = 0; s < 2; ++s) {
                            const u32x2 lo = *(const LAS u32x2*)(rowp + (((2 * s) ^ sw) * 16)), hi = *(const LAS u32x2*)(rowp + (((2 * s + 1) ^ sw) * 16));
                            const u32x4 av = (u32x4){lo.x, lo.y, hi.x, hi.y};
                            O[dt] = MFMA32(__builtin_bit_cast(bf16x8, av), Pb[s], O[dt]); } }
                }
            }
#undef AT_DMA
#pragma unroll
            for (int dt = 0; dt < 4; ++dt)
#pragma unroll
                for (int g = 0; g < 4; ++g) { u32x2 wv; wv.x = pk2(O[dt][4 * g], O[dt][4 * g + 1]); wv.y = pk2(O[dt][4 * g + 2], O[dt][4 * g + 3]);
                    *(u32x2*)(ob + qrow * D + hh * SB_D + 32 * dt + 8 * g + 4 * h) = wv; }
            __syncthreads();
        }
    }
}

constexpr int N_PHASES = 16;
#ifndef MK_ONE_LAUNCH
#define MK_ONE_LAUNCH 1
#endif
#ifndef MK_PROBE_SK
#define MK_PROBE_SK 0
#endif
#ifndef MK_PROBE_MASK
#define MK_PROBE_MASK 0u
#endif
struct KArgs { const float* in[26]; float* out; unsigned char* ws; int ph_lo, ph_hi, li, pad; };

template <int PH> __device__ __forceinline__ void run_phase(const Frame& F, const KArgs& args) {
    unsigned char* ws = args.ws;
    const float* x = args.in[I_X]; const float* meta = args.in[I_META];
    LAS unsigned char* ring = F.lds;
    const int bid = (int)blockIdx.x;
    float* const ZA = (float*)(ws + WS_ZB); float* const ZB2 = (float*)(ws + WS_HF);
    float* const ST1 = (float*)(ws + WS_CTL + CTL_STATS), * const ST2 = ST1 + 2 * RP, * const ST3 = ST2 + 2 * RP, * const ST4 = ST3 + 2 * RP;
    const float* const g_m0 = args.in[I_LNMG]; const float* const b_m0 = args.in[I_LNMB]; const float* const g_f0 = args.in[I_LNFG]; const float* const b_f0 = args.in[I_LNFB];
    const float* const g_m1 = g_m0 + D; const float* const b_m1 = b_m0 + D; const float* const g_f1 = g_f0 + D; const float* const b_f1 = b_f0 + D;
    if constexpr (PH == 0) {
        zero_bytes(F, ws + WS_L1O, L1O_BYTES);
        const TrJob J[9] = {
            {args.in[I_WRKV], D, D, D, D, (bf16_t*)(ws + W0_CAT)},
            {args.in[I_WRKV] + (size_t)D * D, D, D, D, D, (bf16_t*)(ws + W0_CAT) + (size_t)4096 * D},
            {args.in[I_WRKV] + (size_t)2 * D * D, D, D, D, D, (bf16_t*)(ws + W0_CAT) + (size_t)8192 * D},
            {args.in[I_W1], D, 128, D, 256, (bf16_t*)(ws + W0_CAT) + (size_t)12288 * D},
            {args.in[I_A1], D, 128, D, 256, (bf16_t*)(ws + W0_CAT) + (size_t)12544 * D},
            {args.in[I_G1], D, 480, D, 512, (bf16_t*)(ws + W0_CAT) + (size_t)12800 * D},
            {args.in[I_W2], 128, D, 512, D, (bf16_t*)(ws + W0_L2)},
            {args.in[I_A2], 128, D, 512, D, (bf16_t*)(ws + W0_L2) + (size_t)4096 * 512},
            {args.in[I_G2], 480, D, 512, D, (bf16_t*)(ws + W0_L2) + (size_t)8192 * 512}};
        tr_jobs<9>(F, J);
        mix_phase(F, x, meta, args.in[I_MU], (bf16_t*)(ws + WS_X));
    } else if constexpr (PH == 1) {
        { SkP1 Q{(const bf16_t*)(ws + WS_X), (const bf16_t*)(ws + W0_CAT), (bf16_t*)(ws + WS_Y), (bf16_t*)(ws + WS_L1O)}; skinny_gemm<16>(F, D, 814, Q); if (MK_PROBE_SK) skinny_gemm<16>(F, D, 814, Q); }
        ProbP1 P; P.K = D; P.S.init(32, 48, F.G, bid, 8); P.mixed = (const char*)(ws + WS_X); P.wcat = (const char*)(ws + W0_CAT);
        EpiP1 E{(bf16_t*)(ws + WS_Y), (bf16_t*)(ws + WS_L1O)};
        pg8::gemm_phase<ProbP1, EpiP1, true, true>(ring, P, E);
    } else if constexpr (PH == 2) {
        { SkL2 Q{(const bf16_t*)(ws + WS_L1O), (const bf16_t*)(ws + W0_L2), (bf16_t*)(ws + WS_WDEC), (bf16_t*)(ws + WS_AA), (bf16_t*)(ws + WS_GG), args.in[I_W0], args.in[I_A0]}; skinny_gemm<2>(F, 512, 768, Q); if (MK_PROBE_SK) skinny_gemm<2>(F, 512, 768, Q); }
        ProbL2 P; P.K = 512; P.S.init(32, 48, F.G, bid); P.l1o = (const char*)(ws + WS_L1O); P.w2 = (const char*)(ws + W0_L2);
        EpiL2 E{(bf16_t*)(ws + WS_WDEC), (bf16_t*)(ws + WS_AA), (bf16_t*)(ws + WS_GG), args.in[I_W0], args.in[I_A0]};
        pg8::gemm_phase<ProbL2, EpiL2, true, true>(ring, P, E);
    } else if constexpr (PH == 3) {
        ScanArgs A{(const bf16_t*)(ws + WS_Y), (const bf16_t*)(ws + WS_Y) + (size_t)RP * D, (const bf16_t*)(ws + WS_Y) + (size_t)2 * RP * D, (const bf16_t*)(ws + WS_Y) + (size_t)3 * RP * D, (const bf16_t*)(ws + WS_WDEC), (const bf16_t*)(ws + WS_AA),
                   (const bf16_t*)(ws + WS_GG), (bf16_t*)(ws + WS_YG), args.in[I_KK], args.in[I_KA], args.in[I_RK], args.in[I_GNG], args.in[I_GNB]};
        const TrJob J[7] = {
            {args.in[I_RWO], D, D, D, D, (bf16_t*)(ws + W0_O)},
            {args.in[I_WUP], D, FF, D, FF, (bf16_t*)(ws + W0_UP)},
            {args.in[I_WDN], FF, D, FF, D, (bf16_t*)(ws + W0_DN)},
            {args.in[I_SBQKV], D, 3 * D, D, 3 * D, (bf16_t*)(ws + W1_QKV)},
            {args.in[I_SBO], D, D, D, D, (bf16_t*)(ws + W1_O)},
            {args.in[I_WUP] + (size_t)D * FF, D, FF, D, FF, (bf16_t*)(ws + W1_UP)},
            {args.in[I_WDN] + (size_t)D * FF, FF, D, FF, D, (bf16_t*)(ws + W1_DN)}};
        scan_phase(F, A, J);
    } else if constexpr (PH == 4) {
        { SkRes<false> Q{(const bf16_t*)(ws + WS_YG) + (size_t)MREAL * D, D, (const bf16_t*)(ws + W0_O), D, ZA + (size_t)MREAL * D, meta, nullptr, nullptr, nullptr, ST1}; skinny_gemm<16>(F, D, 256, Q); }
        ProbG P; P.K = D; P.S.init(32, 16, F.G, bid); P.A = (const char*)(ws + WS_YG); P.Bt = (const char*)(ws + W0_O);
        EpiRes<false> E{ZA, x, nullptr, nullptr, nullptr, ST1};
        pg8::gemm_phase<ProbG, EpiRes<false>, true, true>(ring, P, E);
    } else if constexpr (PH == 5) {
        ln_apply(F, ZA, ST1, g_m0, b_m0, (bf16_t*)(ws + WS_HB), nullptr, MROWS);
    } else if constexpr (PH == 6) {
        { SkUp Q{(const bf16_t*)(ws + WS_HB) + (size_t)MREAL * D, (const bf16_t*)(ws + W0_UP), (bf16_t*)(ws + WS_U0) + (size_t)MREAL * FF}; skinny_gemm<16>(F, D, 1024, Q); if (MK_PROBE_SK) skinny_gemm<16>(F, D, 1024, Q); }
        ProbG P; P.K = D; P.S.init(32, 64, F.G, bid); P.A = (const char*)(ws + WS_HB); P.Bt = (const char*)(ws + W0_UP);
        EpiUp E{(bf16_t*)(ws + WS_U0)};
        pg8::gemm_phase<ProbG, EpiUp, true, true>(ring, P, E);
    } else if constexpr (PH == 7) {
        { SkRes<true> Q{(const bf16_t*)(ws + WS_U0) + (size_t)MREAL * FF, FF, (const bf16_t*)(ws + W0_DN), FF, ZB2 + (size_t)MREAL * D, ZA + (size_t)MREAL * D, ST1, g_m0, b_m0, ST2}; skinny_gemm<16>(F, FF, 256, Q); }
        ProbG P; P.K = FF; P.S.init(32, 16, F.G, bid); P.A = (const char*)(ws + WS_U0); P.Bt = (const char*)(ws + W0_DN);
        EpiRes<true> E{ZB2, ZA, ST1, g_m0, b_m0, ST2};
        pg8::gemm_phase<ProbG, EpiRes<true>, true, true>(ring, P, E);
    } else if constexpr (PH == 8) {
        ln_apply(F, ZB2, ST2, g_f0, b_f0, (bf16_t*)(ws + WS_HB), nullptr, MROWS);
    } else if constexpr (PH == 9) {
        { SkKv Q{(const bf16_t*)(ws + WS_HB) + (size_t)MREAL * D, (const bf16_t*)(ws + W1_QKV) + (size_t)D * D, (bf16_t*)(ws + WS_KB) + (size_t)MREAL * D}; skinny_gemm<16>(F, D, 512, Q); if (MK_PROBE_SK) skinny_gemm<16>(F, D, 512, Q); }
        ProbQkv P; P.K = D; P.S.init(32, 48, F.G, bid); P.hb = (const char*)(ws + WS_HB); P.w = (const char*)(ws + W1_QKV);
        EpiQkv E{(bf16_t*)(ws + WS_QB)};
        pg8::gemm_phase<ProbQkv, EpiQkv, true, true>(ring, P, E);
    } else if constexpr (PH == 10) {
        attn_phase(F, (const bf16_t*)(ws + WS_QB), (const bf16_t*)(ws + WS_KB), (const bf16_t*)(ws + WS_VB), (bf16_t*)(ws + WS_OB));
    } else if constexpr (PH == 11) {
        ProbG P; P.K = D; P.S.init(32, 16, F.G, bid); P.A = (const char*)(ws + WS_OB); P.Bt = (const char*)(ws + W1_O);
        EpiRes<true> E{ZA, ZB2, ST2, g_f0, b_f0, ST3};
        pg8::gemm_phase<ProbG, EpiRes<true>, true, true>(ring, P, E);
    } else if constexpr (PH == 12) {
        ln_apply(F, ZA, ST3, g_m1, b_m1, (bf16_t*)(ws + WS_HB), nullptr, MREAL);
    } else if constexpr (PH == 13) {
        ProbG P; P.K = D; P.S.init(32, 64, F.G, bid); P.A = (const char*)(ws + WS_HB); P.Bt = (const char*)(ws + W1_UP);
        EpiUp E{(bf16_t*)(ws + WS_U1)};
        pg8::gemm_phase<ProbG, EpiUp, true, true>(ring, P, E);
    } else if constexpr (PH == 14) {
        ProbG P; P.K = FF; P.S.init(32, 16, F.G, bid); P.A = (const char*)(ws + WS_U1); P.Bt = (const char*)(ws + W1_DN);
        EpiRes<true> E{ZB2, ZA, ST3, g_m1, b_m1, ST4};
        pg8::gemm_phase<ProbG, EpiRes<true>, true, true>(ring, P, E);
    } else if constexpr (PH == 15) {
        ln_apply(F, ZB2, ST4, g_f1, b_f1, nullptr, args.out, MREAL);
    }
}

__global__ void __launch_bounds__(NWAVES * 64, 2) fwd_kernel(KArgs args) {
    extern __shared__ __attribute__((aligned(16))) unsigned char lds_raw[];
    Frame F;
    F.lds = (LAS unsigned char*)lds_raw;
    F.tid = threadIdx.x; F.lane = F.tid & 63; F.wave = __builtin_amdgcn_readfirstlane(F.tid >> 6);
    F.G = gridDim.x; { const int bx = blockIdx.x; F.vcu = (F.G % 8 == 0) ? (bx % 8) * (F.G / 8) + bx / 8 : bx; }
    volatile LAS unsigned* MISC = (volatile LAS unsigned*)(F.lds + MISC_OFF);
    for (int u = F.tid; u < (LDS_BYTES - LDSCTL_OFF) / 4; u += NWAVES * 64) ((LAS unsigned*)(F.lds + LDSCTL_OFF))[u] = 0u;
    __syncthreads();
    unsigned* ctl = (unsigned*)(args.ws + WS_CTL);
    const int lo = args.ph_lo, hi = args.ph_hi;
    XcdBarrier bar; bar.bar = ctl + CW_BAR + args.li * XCD_BAR_WORDS; bar.x = 0; bar.st = nullptr;
    if (hi - lo > 1 || MK_PROBE_MASK != 0u) bar = xcd_barrier_post(ctl + CW_BAR + args.li * XCD_BAR_WORDS, MISC + 8);
#ifndef ONLY_PHASE
#define ONLY_PHASE -1
#endif
#define IN(k) ((ONLY_PHASE < 0 || ONLY_PHASE == (k)) && lo <= (k) && (k) < hi)
#define PHASE(k) do { if (IN(k)) { run_phase<k>(F, args); if constexpr (((MK_PROBE_MASK) >> (k)) & 1u) { xcd_barrier(bar); run_phase<k>(F, args); } } \
                      if (IN(k) && IN((k) + 1)) xcd_barrier(bar); } while (0)
    PHASE(0); PHASE(1); PHASE(2); PHASE(3); PHASE(4); PHASE(5); PHASE(6); PHASE(7);
    PHASE(8); PHASE(9); PHASE(10); PHASE(11); PHASE(12); PHASE(13); PHASE(14); PHASE(15);
#undef IN
#undef PHASE
}

extern "C" void kernel_launch(void* const* d_in, const int* in_sizes, int n_in, void* d_out, int out_size, void* d_ws, size_t ws_size, hipStream_t stream) {
    static int grid = 0;
    if (grid == 0) {
        if (n_in != 26 || in_sizes[0] != MREAL * D || out_size != MREAL * D || ws_size < WS_END) {
            fprintf(stderr, "kernel_launch: unexpected shapes (n_in %d, in0 %d, out %d, ws %zu, need %zu); nothing launched\n", n_in, n_in > 0 ? in_sizes[0] : -1, out_size, ws_size, (size_t)WS_END); grid = -1; return; }
        int dev = 0, cus = 0, per_cu = 0;
        if (hipGetDevice(&dev) != hipSuccess || hipDeviceGetAttribute(&cus, hipDeviceAttributeMultiprocessorCount, dev) != hipSuccess) { grid = -1; return; }
        if (hipFuncSetAttribute((const void*)fwd_kernel, hipFuncAttributeMaxDynamicSharedMemorySize, LDS_BYTES) != hipSuccess) { fprintf(stderr, "kernel_launch: hipFuncSetAttribute failed\n"); grid = -1; return; }
        if (hipOccupancyMaxActiveBlocksPerMultiprocessor(&per_cu, (const void*)fwd_kernel, NWAVES * 64, LDS_BYTES) != hipSuccess || per_cu < 1)
            fprintf(stderr, "kernel_launch: note: occupancy query reports %d workgroups per CU\n", per_cu);
        (void)hipGetLastError();
        grid = cus;
    }
    if (grid < 0) return;
    if (hipMemsetAsync((char*)d_ws + WS_CTL, 0, CTL_ZERO_BYTES, stream) != hipSuccess) return;
    KArgs a{};
    for (int i = 0; i < 26; ++i) a.in[i] = (const float*)d_in[i];
    a.out = (float*)d_out; a.ws = (unsigned char*)d_ws; a.pad = 0;
#if MK_ONE_LAUNCH
    a.ph_lo = 0; a.ph_hi = N_PHASES; a.li = 0;
    hipLaunchKernelGGL(fwd_kernel, dim3(grid), dim3(NWAVES * 64), LDS_BYTES, stream, a);
#else
    for (int p = 0; p < N_PHASES; ++p) { a.ph_lo = p; a.ph_hi = p + 1; a.li = p;
        hipLaunchKernelGGL(fwd_kernel, dim3(grid), dim3(NWAVES * 64), LDS_BYTES, stream, a); }
#endif
}
```
